# Optimizing an MI355X kernel written in HIP

```python
import jax, jax.numpy as jnp
from jax import lax
import numpy as np

D_MODEL = 1024
BATCH = 4
SEQ = 4096
DEPTH = 1

N_META = 16
EPS = 1e-6
D_FF = 2816
CHUNK = 64
A_DK = 128
A_DV = 128
A_HEADS = D_MODEL // A_DV
A_CONV = 4
A_WK = A_HEADS * A_DK
A_WV = A_HEADS * A_DV
B_N = 64
B_HEADS = D_MODEL // B_N
B_W = B_HEADS * B_N
W_LORA = 64
AA_LORA = 64
G_LORA = 160
B_GN_EPS = B_N * 1e-5
B_COLS = 3 * B_W + W_LORA + AA_LORA + G_LORA
IN_SIZES = (A_WK, A_WK, A_WV, A_WV, A_HEADS, A_HEADS, B_COLS, D_MODEL, D_MODEL)
IN_TOTAL = sum(IN_SIZES)

kernel_name = "meta_macaron_deltanet_rwkv7_hybrid"


def _offsets(sizes):
    out, acc = [], 0
    for s in sizes[:-1]:
        acc += s
        out.append(acc)
    return out


def _rmsnorm(x, gain):
    xf = x.astype(jnp.float32)
    y = xf * lax.rsqrt(jnp.mean(xf * xf, axis=-1, keepdims=True) + EPS)
    return (y * gain.astype(jnp.float32)).astype(x.dtype)


def _l2norm(x):
    xf = x.astype(jnp.float32)
    return xf * lax.rsqrt(jnp.sum(xf * xf, axis=-1, keepdims=True) + 1e-6)


def _swiglu(x, w_gu, w_down):
    gate, up = jnp.split(x @ w_gu, 2, axis=-1)
    return (jax.nn.silu(gate) * up) @ w_down


def _causal_dwconv(x, w):
    k = w.shape[0]
    return lax.conv_general_dilated(x, w[:, None, :].astype(x.dtype), window_strides=(1,),
                                    padding=[(k - 1, 0)], dimension_numbers=('NWC', 'WIO', 'NWC'),
                                    feature_group_count=x.shape[-1])


def _gated_delta_chunked(q, k, v, beta, g):
    b, h, t, dk = q.shape
    dv = v.shape[-1]
    n = t // CHUNK

    def ch(z):
        return z.reshape((b, h, n, CHUNK) + z.shape[3:])

    q, k, v, beta, g = ch(q), ch(k), ch(v), ch(beta), ch(g)
    g = jnp.cumsum(g, axis=-1)
    kb = k * beta[..., None]
    vb = v * beta[..., None]
    idx = jnp.arange(CHUNK)
    incl = idx[:, None] >= idx[None, :]
    strict = idx[:, None] > idx[None, :]
    diff = g[..., :, None] - g[..., None, :]
    decay = jnp.where(incl, jnp.exp(jnp.where(incl, diff, 0.0)), 0.0)
    m = jnp.where(strict, jnp.einsum('bhncd,bhnsd->bhncs', kb, k) * decay, 0.0)
    eye = jnp.eye(CHUNK, dtype=m.dtype)
    tinv = lax.linalg.triangular_solve(m + eye, jnp.broadcast_to(eye, m.shape), left_side=True,
                                       lower=True, unit_diagonal=True)
    u = jnp.einsum('bhncs,bhnsd->bhncd', tinv, vb)
    wk = jnp.einsum('bhncs,bhnsd->bhncd', tinv, kb * jnp.exp(g)[..., None])
    attn = jnp.einsum('bhncd,bhnsd->bhncs', q, k) * decay
    qg = q * jnp.exp(g)[..., None]
    g_last = g[..., -1]
    k_tail = k * jnp.exp(g_last[..., None] - g)[..., None]

    def step(state, inp):
        u_i, w_i, attn_i, qg_i, kt_i, gl_i = inp
        v_new = u_i - jnp.einsum('bhcd,bhde->bhce', w_i, state)
        o = jnp.einsum('bhcd,bhde->bhce', qg_i, state) + jnp.einsum('bhcs,bhse->bhce', attn_i, v_new)
        state = state * jnp.exp(gl_i)[..., None, None] + jnp.einsum('bhcd,bhce->bhde', kt_i, v_new)
        return state, o

    xs = (jnp.moveaxis(u, 2, 0), jnp.moveaxis(wk, 2, 0), jnp.moveaxis(attn, 2, 0),
          jnp.moveaxis(qg, 2, 0), jnp.moveaxis(k_tail, 2, 0), jnp.moveaxis(g_last, 2, 0))
    s0 = jnp.zeros((b, h, dk, dv), jnp.float32)
    _, o = lax.scan(step, s0, xs)
    return jnp.moveaxis(o, 0, 2).reshape(b, h, t, dv)


def _deltanet_branch(q, k, v, z, beta_pre, alpha_pre, conv_w, log_rate, dt_bias, out_gain):
    bsz, t, _ = q.shape
    qkv = jax.nn.silu(_causal_dwconv(jnp.concatenate([q, k, v], axis=-1), conv_w))
    q, k, v = jnp.split(qkv, [A_WK, 2 * A_WK], axis=-1)
    q = _l2norm(q.reshape(bsz, t, A_HEADS, A_DK)) * (A_DK ** -0.5)
    k = _l2norm(k.reshape(bsz, t, A_HEADS, A_DK))
    v = v.reshape(bsz, t, A_HEADS, A_DV).astype(jnp.float32)
    beta = jax.nn.sigmoid(beta_pre.astype(jnp.float32))
    g = -jnp.exp(log_rate.astype(jnp.float32)) * jax.nn.softplus(
        alpha_pre.astype(jnp.float32) + dt_bias.astype(jnp.float32))
    pad = CHUNK - N_META

    def prep(a):
        a = jnp.pad(a, ((0, 0), (pad, 0)) + ((0, 0),) * (a.ndim - 2))
        return jnp.moveaxis(a, 2, 1)

    o = _gated_delta_chunked(prep(q), prep(k), prep(v), prep(beta), prep(g))
    o = jnp.moveaxis(o, 1, 2)[:, pad:]
    o = o * lax.rsqrt(jnp.mean(o * o, axis=-1, keepdims=True) + EPS) * out_gain.astype(jnp.float32)
    o = o.reshape(bsz, t, A_WV) * jax.nn.silu(z.astype(jnp.float32))
    return o.astype(z.dtype)


def _rwkv7_scan(r, w, k, v, a_vec, b_vec):
    def step(state, inp):
        r_t, w_t, k_t, v_t, a_t, b_t = inp
        sa = jnp.einsum('bhvk,bhk->bhv', state, a_t)
        state = state * w_t[:, :, None, :] + sa[..., None] * b_t[:, :, None, :] \
            + v_t[..., None] * k_t[:, :, None, :]
        return state, jnp.einsum('bhvk,bhk->bhv', state, r_t)

    bsz, t, h, n = r.shape
    xs = tuple(jnp.moveaxis(a, 1, 0) for a in (r, w, k, v, a_vec, b_vec))
    s0 = jnp.zeros((bsz, h, n, n), jnp.float32)
    _, y = lax.scan(step, s0, xs)
    return jnp.moveaxis(y, 0, 1)


def _rwkv7_branch(zb, mu, w0, w_up, a0, a_up, g_up, k_k, k_a, r_k, ln_gain, ln_bias):
    bsz, t, _ = zb.shape
    f32 = jnp.float32
    zf = zb.astype(f32)
    prev = jnp.pad(zf, ((0, 0), (1, 0), (0, 0)))[:, :-1]
    zf = zf + (prev - zf) * mu.astype(f32)
    r, k, v, wd, ad, gd = jnp.split(
        zf, [B_W, 2 * B_W, 3 * B_W, 3 * B_W + W_LORA, 3 * B_W + W_LORA + AA_LORA], axis=-1)
    w_log = -jax.nn.softplus(-(w0.astype(f32) + jnp.tanh(wd) @ w_up.astype(f32))) - 0.5
    decay = jnp.exp(-jnp.exp(w_log))
    a = jax.nn.sigmoid(a0.astype(f32) + ad @ a_up.astype(f32))
    gate = jax.nn.sigmoid(gd) @ g_up.astype(f32)
    hs = (bsz, t, B_HEADS, B_N)
    kk = _l2norm((k * k_k.astype(f32)).reshape(hs))
    k = k * (1.0 + (a - 1.0) * k_a.astype(f32))
    r, k, v, decay, a = r.reshape(hs), k.reshape(hs), v.reshape(hs), decay.reshape(hs), a.reshape(hs)
    y = _rwkv7_scan(r, decay, k, v, -kk, kk * a)
    mean = jnp.mean(y, axis=-1, keepdims=True)
    var = jnp.mean(jnp.square(y - mean), axis=-1, keepdims=True)
    y = (y - mean) * lax.rsqrt(var + B_GN_EPS) * ln_gain.astype(f32).reshape(B_HEADS, B_N) \
        + ln_bias.astype(f32).reshape(B_HEADS, B_N)
    y = y + jnp.sum(r * k * r_k.astype(f32), axis=-1, keepdims=True) * v
    return (y.reshape(bsz, t, B_W) * gate).astype(zb.dtype)


def setup_inputs(seed: int = 0) -> dict:
    key = jax.random.key(seed)
    ks = jax.random.split(key, 32)
    f32 = jnp.float32

    def nrm(k, shape, scale):
        return jax.random.normal(k, shape, f32) * scale

    def gain(k, shape):
        return 1.0 + 0.02 * jax.random.normal(k, shape, f32)

    dt = jnp.exp(jax.random.uniform(ks[8], (DEPTH, A_HEADS), f32, np.log(1e-3), np.log(1e-1)))
    return {
        "x": nrm(ks[0], (BATCH, SEQ, D_MODEL), 1.0),
        "meta_tokens": nrm(ks[1], (N_META, D_MODEL), 1.0),
        "ffn1_norm": gain(ks[2], (DEPTH, D_MODEL)),
        "ffn1_w_gu": nrm(ks[3], (DEPTH, D_MODEL, 2 * D_FF), D_MODEL ** -0.5),
        "ffn1_w_down": nrm(ks[4], (DEPTH, D_FF, D_MODEL), D_FF ** -0.5),
        "mix_norm": gain(ks[5], (DEPTH, D_MODEL)),
        "w_in": nrm(ks[6], (DEPTH, D_MODEL, IN_TOTAL), D_MODEL ** -0.5),
        "a_conv_w": nrm(ks[7], (DEPTH, A_CONV, 2 * A_WK + A_WV), A_CONV ** -0.5),
        "a_log_rate": jnp.log(jax.random.uniform(ks[9], (DEPTH, A_HEADS), f32, 1.0, 16.0)),
        "a_dt_bias": dt + jnp.log(-jnp.expm1(-dt)),
        "a_out_norm": gain(ks[10], (DEPTH, A_DV)),
        "b_shift_mu": jax.random.uniform(ks[11], (DEPTH, B_COLS), f32, 0.0, 1.0),
        "b_w0": jax.random.uniform(ks[12], (DEPTH, B_W), f32, -6.5, -1.5),
        "b_w_up": nrm(ks[13], (DEPTH, W_LORA, B_W), 0.5 * W_LORA ** -0.5),
        "b_a0": nrm(ks[14], (DEPTH, B_W), 0.1),
        "b_a_up": nrm(ks[15], (DEPTH, AA_LORA, B_W), AA_LORA ** -0.5),
        "b_g_up": nrm(ks[16], (DEPTH, G_LORA, B_W), G_LORA ** -0.5),
        "b_k_k": 0.85 + 0.05 * jax.random.normal(ks[17], (DEPTH, B_W), f32),
        "b_k_a": 1.0 + 0.05 * jax.random.normal(ks[18], (DEPTH, B_W), f32),
        "b_r_k": nrm(ks[19], (DEPTH, B_HEADS, B_N), 0.1),
        "b_ln_gain": gain(ks[20], (DEPTH, B_W)),
        "b_ln_bias": nrm(ks[21], (DEPTH, B_W), 0.02),
        "w_out": nrm(ks[22], (DEPTH, D_MODEL, D_MODEL), D_MODEL ** -0.5),
        "ffn2_norm": gain(ks[23], (DEPTH, D_MODEL)),
        "ffn2_w_gu": nrm(ks[24], (DEPTH, D_MODEL, 2 * D_FF), D_MODEL ** -0.5),
        "ffn2_w_down": nrm(ks[25], (DEPTH, D_FF, D_MODEL), D_FF ** -0.5),
        "final_norm": gain(ks[26], (D_MODEL,)),
    }


def reference(x, meta_tokens, ffn1_norm, ffn1_w_gu, ffn1_w_down, mix_norm, w_in, a_conv_w,
              a_log_rate, a_dt_bias, a_out_norm, b_shift_mu, b_w0, b_w_up, b_a0, b_a_up, b_g_up,
              b_k_k, b_k_a, b_r_k, b_ln_gain, b_ln_bias, w_out, ffn2_norm, ffn2_w_gu, ffn2_w_down,
              final_norm):
    bsz = x.shape[0]
    meta = jnp.broadcast_to(meta_tokens[None].astype(x.dtype), (bsz, N_META, D_MODEL))
    h = jnp.concatenate([meta, x], axis=1)
    for l in range(DEPTH):
        h = h + 0.5 * _swiglu(_rmsnorm(h, ffn1_norm[l]), ffn1_w_gu[l], ffn1_w_down[l])
        u = _rmsnorm(h, mix_norm[l])
        aq, ak, av, az, abeta, aalpha, bcols, ga, gb = jnp.split(u @ w_in[l], _offsets(IN_SIZES), axis=-1)
        o_a = _deltanet_branch(aq, ak, av, az, abeta, aalpha, a_conv_w[l], a_log_rate[l],
                               a_dt_bias[l], a_out_norm[l])
        o_b = _rwkv7_branch(bcols, b_shift_mu[l], b_w0[l], b_w_up[l], b_a0[l], b_a_up[l], b_g_up[l],
                            b_k_k[l], b_k_a[l], b_r_k[l], b_ln_gain[l], b_ln_bias[l])
        merged = jax.nn.sigmoid(ga) * o_a + jax.nn.sigmoid(gb) * o_b
        h = h + merged @ w_out[l]
        h = h + 0.5 * _swiglu(_rmsnorm(h, ffn2_norm[l]), ffn2_w_gu[l], ffn2_w_down[l])
    return _rmsnorm(h, final_norm)[:, N_META:]
```

```cpp
#include <hip/hip_runtime.h>
#include <hip/hip_cooperative_groups.h>
#include <stdint.h>
#include <stdio.h>
namespace cg = cooperative_groups;

typedef unsigned short bf16_t;
using bf16x8 = __attribute__((ext_vector_type(8))) short;
using f32x16 = __attribute__((ext_vector_type(16))) float;

#define DEV __device__ __forceinline__

constexpr int NB = 4, SEQ = 4096, NMETA = 16, TT = 4112, MTOT = NB * TT;
constexpr int DM = 1024, DFF = 2816, NIN = 9520, NINP = 9728;
constexpr int MH = 2 * TT;
constexpr int NCHUNK = 65;
constexpr int ZRW = 4112;
constexpr float EPS = 1e-6f;

constexpr size_t A_WGU1 = 0;
constexpr size_t A_WD1 = A_WGU1 + (size_t)2 * DFF * DM;
constexpr size_t A_WIN = A_WD1 + (size_t)DM * DFF;
constexpr size_t A_WOUT = A_WIN + (size_t)NINP * DM;
constexpr size_t A_WGU2 = A_WOUT + (size_t)DM * DM;
constexpr size_t A_WD2 = A_WGU2 + (size_t)2 * DFF * DM;
constexpr size_t A_GUP = A_WD2 + (size_t)DM * DFF;
constexpr size_t A_END = A_GUP + (size_t)DM * 192;
static_assert(A_END * 2 <= (size_t)NB * SEQ * DM * 4, "arena overflow");

constexpr size_t W_HB = 0;
constexpr size_t W_SS = W_HB + (size_t)MTOT * DM * 2;
constexpr size_t W_Z = W_SS + (size_t)4 * MTOT * 4;
constexpr size_t W_ACT = W_Z;
constexpr size_t W_H3 = W_Z + (size_t)MTOT * DFF * 2;
constexpr size_t W_BA = W_Z + (size_t)MH * NIN * 2;
constexpr size_t W_GB = W_BA + (size_t)MH * 16 * 4;
constexpr size_t W_BB = W_GB + (size_t)16 * NCHUNK * 64 * 4;
constexpr size_t W_TT = W_BB + (size_t)16 * NCHUNK * 64 * 4;
constexpr size_t W_OA = W_TT + (size_t)16 * NCHUNK * 4096 * 2;
constexpr size_t W_OST = W_OA + (size_t)MH * DM * 2;
constexpr size_t W_YB = W_OST + (size_t)MH * 32 * 4;
constexpr size_t W_YST = W_YB + (size_t)MH * DM * 2;
constexpr size_t W_BON = W_YST + (size_t)MH * 128 * 4;
constexpr size_t W_SG = W_BON + (size_t)MH * DM * 2;
constexpr size_t W_END = W_SG + (size_t)MH * 192 * 2;
constexpr size_t W_BAR = (W_END + 255) / 256 * 256;
constexpr size_t W_XWA = W_BAR + 4096;
static_assert(W_XWA + (size_t)MH * 128 * 2 <= (size_t)256 * 1024 * 1024, "ws overflow");
static_assert(W_H3 + (size_t)MTOT * DM * 4 <= (size_t)256 * 1024 * 1024, "ws overflow h3");

constexpr int LDS_BYTES = 147456;

struct P {
  const float *x, *meta, *ffn1_norm, *ffn1_wgu, *ffn1_wd, *mix_norm, *w_in, *conv_w, *log_rate, *dt_bias, *out_norm,
      *mu, *w0, *w_up, *a0, *a_up, *g_up, *k_k, *k_a, *r_k, *ln_g, *ln_b, *w_out, *ffn2_norm, *ffn2_wgu, *ffn2_wd,
      *final_norm;
  float* out;
  char* ws;
};

DEV bf16_t f2bf(float f) {
  uint32_t u = __float_as_uint(f);
  u += 0x7fffu + ((u >> 16) & 1u);
  return (bf16_t)(u >> 16);
}
DEV float bf2f(bf16_t b) { return __uint_as_float(((uint32_t)b) << 16); }
DEV uint32_t pack2(float a, float b) { return (uint32_t)f2bf(a) | ((uint32_t)f2bf(b) << 16); }
DEV float rcpf_(float x) { return __builtin_amdgcn_rcpf(x); }
DEV float sigmoidf_(float x) { return rcpf_(1.f + __expf(-x)); }
DEV float siluf_(float x) { return x * rcpf_(1.f + __expf(-x)); }
DEV float softplusf_(float x) { return x > 20.f ? x : log1pf(__expf(x)); }

template <int CTRL>
DEV float dpp_f(float v) {
  return __int_as_float(__builtin_amdgcn_update_dpp(0, __float_as_int(v), CTRL, 0xf, 0xf, true));
}
DEV float red16(float v) {
  v += dpp_f<0xB1>(v);
  v += dpp_f<0x4E>(v);
  v += dpp_f<0x141>(v);
  v += dpp_f<0x140>(v);
  return v;
}
DEV float red32(float v) { v = red16(v); v += __shfl_xor(v, 16); return v; }
DEV float red64(float v) { v = red32(v); v += __shfl_xor(v, 32); return v; }

DEV const float* h0row(const P& p, int m) {
  int b = m / TT, t = m - b * TT;
  return t < NMETA ? p.meta + (size_t)t * DM : p.x + ((size_t)b * SEQ + (t - NMETA)) * DM;
}

DEV f32x16 mm32(const bf16_t* A, int lda, const bf16_t* Bt, int ldb, int K, f32x16 acc, int lane) {
  const bf16_t* ap = A + (lane & 31) * lda + (lane >> 5) * 8;
  const bf16_t* bp = Bt + (lane & 31) * ldb + (lane >> 5) * 8;
  for (int k = 0; k < K; k += 16) {
    bf16x8 a = *(const bf16x8*)(ap + k);
    bf16x8 b = *(const bf16x8*)(bp + k);
    acc = __builtin_amdgcn_mfma_f32_32x32x16_bf16(a, b, acc, 0, 0, 0);
  }
  return acc;
}
DEV int otid() { int t = threadIdx.x; asm volatile("" : "+v"(t)); return t; }
#define WAVE_FENCE() asm volatile("s_waitcnt lgkmcnt(0)" ::: "memory")
DEV int rowof(int r, int lane) { return 8 * (r >> 2) + 4 * (lane >> 5) + (r & 3); }

__device__ __forceinline__ void convert_matrix(const float* __restrict__ src, int Ksrc, int Nsrc, bf16_t* __restrict__ dst, int Rows,
                               int validRows, int Kdst, const float* __restrict__ scale, int mode, char* smem) {
  float* tile = (float*)smem;
  constexpr int NU = 4;
  const int tid = otid();
  const int kt_n = Kdst / 64;
  const int units = (Rows / 64) * kt_n;
  for (int u0 = blockIdx.x; u0 < units; u0 += NU * gridDim.x) {
    float v[NU][8];
#pragma unroll
    for (int w = 0; w < NU; w++) {
      const int u = u0 + w * gridDim.x;
      const int R0 = (u / kt_n) * 64, k0 = (u % kt_n) * 64;
#pragma unroll
      for (int q = 0; q < 8; q++) {
        const int e = tid + 512 * q;
        const int kk = e >> 6, rr = e & 63;
        const int R = R0 + rr, k = k0 + kk;
        float x = 0.f;
        if (u < units && R < validRows && k < Ksrc) {
          int col = R;
          if (mode == 1) {
            int j = R >> 7, r = R & 127;
            int wn = r >> 6, i = (r >> 5) & 1, pp = r & 31;
            col = (i ? DFF : 0) + j * 64 + wn * 32 + pp;
          }
          x = src[(size_t)k * Nsrc + col];
          if (scale) x *= scale[k];
        }
        v[w][q] = x;
      }
    }
#pragma unroll
    for (int w = 0; w < NU; w++)
#pragma unroll
      for (int q = 0; q < 8; q++) {
        const int e = tid + 512 * q;
        tile[w * 4160 + (e & 63) * 65 + (e >> 6)] = v[w][q];
      }
    __syncthreads();
#pragma unroll
    for (int w = 0; w < NU; w++) {
      const int u = u0 + w * gridDim.x;
      if (u < units) {
        const int R0 = (u / kt_n) * 64, k0 = (u % kt_n) * 64;
        const int rr = tid >> 3, kk0 = (tid & 7) * 8;
        const float* tp = tile + w * 4160 + rr * 65 + kk0;
        *(uint4*)(dst + (size_t)(R0 + rr) * Kdst + k0 + kk0) =
            make_uint4(pack2(tp[0], tp[1]), pack2(tp[2], tp[3]), pack2(tp[4], tp[5]), pack2(tp[6], tp[7]));
      }
    }
    __syncthreads();
  }
}

__device__ __forceinline__ void phase0(const P& p, char* smem) {
  bf16_t* arena = (bf16_t*)p.out;
  convert_matrix(p.ffn1_wgu, DM, 2 * DFF, arena + A_WGU1, 2 * DFF, 2 * DFF, DM, p.ffn1_norm, 1, smem);
  convert_matrix(p.ffn1_wd, DFF, DM, arena + A_WD1, DM, DM, DFF, nullptr, 0, smem);
  convert_matrix(p.w_in, DM, NIN, arena + A_WIN, NINP, NIN, DM, p.mix_norm, 0, smem);
  convert_matrix(p.w_out, DM, DM, arena + A_WOUT, DM, DM, DM, nullptr, 0, smem);
  convert_matrix(p.ffn2_wgu, DM, 2 * DFF, arena + A_WGU2, 2 * DFF, 2 * DFF, DM, p.ffn2_norm, 1, smem);
  convert_matrix(p.ffn2_wd, DFF, DM, arena + A_WD2, DM, DM, DFF, nullptr, 0, smem);
  convert_matrix(p.g_up, 160, DM, arena + A_GUP, DM, DM, 192, nullptr, 0, smem);
  bf16_t* hb = (bf16_t*)(p.ws + W_HB);
  float* ss = (float*)(p.ws + W_SS);
  const int tid_ = otid();
  const int lane = tid_ & 63, wv = tid_ >> 6;
  for (int m = blockIdx.x * 8 + wv; m < MTOT; m += gridDim.x * 8) {
    const float* src = h0row(p, m);
    float s = 0.f;
    float4 v4[4];
#pragma unroll
    for (int q = 0; q < 4; q++) v4[q] = *(const float4*)(src + q * 256 + lane * 4);
#pragma unroll
    for (int q = 0; q < 4; q++) {
      int c = q * 256 + lane * 4;
      float4 v = v4[q];
      uint32_t lo = pack2(v.x, v.y), hi = pack2(v.z, v.w);
      float a0 = bf2f(lo & 0xffff), a1 = bf2f(lo >> 16), a2 = bf2f(hi & 0xffff), a3 = bf2f(hi >> 16);
      s += a0 * a0 + a1 * a1 + a2 * a2 + a3 * a3;
      *(uint2*)(hb + (size_t)m * DM + c) = make_uint2(lo, hi);
    }
    s = red64(s);
    if (lane == 0) { ss[m] = s; ss[MTOT + m] = 0.f; ss[2 * MTOT + m] = 0.f; ss[3 * MTOT + m] = 0.f; }
  }
}

using u32x4 = __attribute__((ext_vector_type(4))) unsigned;
DEV void gld16(u32x4& r, const void* ptr) { asm volatile("global_load_dwordx4 %0, %1, off" : "=v"(r) : "v"(ptr) : "memory"); }
#define GLD_WAIT() asm volatile("s_waitcnt vmcnt(0)" ::: "memory")
DEV void gld16s(u32x4& r, const void* base, uint32_t off) {
  asm volatile("s_nop 4\n\tglobal_load_dwordx4 %0, %1, %2" : "=v"(r) : "v"(off), "s"(base) : "memory");
}
enum { EPI_SWIGLU = 0, EPI_DOWN1, EPI_WIN, EPI_MERGE, EPI_WOUT, EPI_DOWN2 };

struct EA {
  const P* p;
  int half;
};


template <int EPI, int SPLIT = 0>
__device__ __forceinline__ void gemm_phase(const P& p, char* smem_all, const bf16_t* __restrict__ X, int ldx, int Mrows,
                           const bf16_t* __restrict__ W, int K, int Ntiles, int half, bool dry_in = false) {
  constexpr int MT = SPLIT ? 128 : 256;
  constexpr int NTHR = SPLIT ? 256 : 512;
  constexpr int RSTEP = NTHR / 8;
  constexpr int NWL = 128 / RSTEP, NXL = MT / RSTEP;
  constexpr int STAGE = (128 + MT) * 72 * 2;
  const int tid = otid(), lane = tid & 63, wv = tid >> 6;
  const int grp = SPLIT ? (wv >> 2) : 0;
  const int wl = SPLIT ? (wv & 3) : wv;
  const int wn = wl & 1, wm = wl >> 1;
  char* smem = smem_all + grp * (2 * STAGE);
  const int Mtiles = (Mrows + MT - 1) / MT;
  const int total = Mtiles * Ntiles;
  const int KT = K / 64;
  const int gt = SPLIT ? (tid & 255) : tid;
  const int lrow = gt >> 3, lcol = (gt & 7) * 8;
  float* ss = (float*)(p.ws + W_SS);
  bf16_t* hb = (bf16_t*)(p.ws + W_HB);
  const int tstep = SPLIT ? 2 : 1;
  const int G8 = (gridDim.x & 7) == 0 ? (int)(gridDim.x >> 3) : 0;
  const int pb = (G8 && !SPLIT) ? (int)((blockIdx.x & 7) * G8 + (blockIdx.x >> 3)) : (int)blockIdx.x;
  const int mfull = (Mtiles >> 2) << 2, nfull = mfull * Ntiles, mrem = Mtiles - mfull;
  for (int tbase = pb * tstep; tbase < total; tbase += gridDim.x * tstep) {
    int tile = tbase + grp;
    const bool dry = dry_in || (tile >= total);
    tile = tile < total ? tile : total - 1;
    int mt, nt;
    if (SPLIT) { mt = tile / Ntiles; nt = tile - mt * Ntiles; }
    else if (tile < nfull) {
      const int rg = tile / (4 * Ntiles), rem = tile - rg * 4 * Ntiles;
      nt = rem >> 2;
      mt = rg * 4 + (rem & 3);
    } else {
      const int rem = tile - nfull;
      nt = rem / mrem;
      mt = mfull + (rem - nt * mrem);
    }
    const int m0 = mt * MT, n0 = nt * 128;
    u32x4 w0r[NWL], x0r[NXL], w1r[NWL], x1r[NXL];
    f32x16 acc[2][2];
#pragma unroll
    for (int i = 0; i < 2; i++)
#pragma unroll
      for (int j = 0; j < 2; j++)
#pragma unroll
        for (int r = 0; r < 16; r++) acc[i][j][r] = 0.f;

    uint32_t woff[NWL], xoff[NXL];
#pragma unroll
    for (int q = 0; q < NWL; q++) woff[q] = (uint32_t)(((size_t)(n0 + lrow + RSTEP * q) * K + lcol) * 2);
#pragma unroll
    for (int q = 0; q < NXL; q++) {
      int row = m0 + lrow + RSTEP * q;
      row = row < Mrows ? row : Mrows - 1;
      xoff[q] = (uint32_t)(((size_t)row * ldx + lcol) * 2);
    }
    auto gload = [&](u32x4 (&wr)[NWL], u32x4 (&xr)[NXL], int kt) {
      const bf16_t* wb = W + kt * 64;
      const bf16_t* xb = X + kt * 64;
#pragma unroll
      for (int q = 0; q < NWL; q++) gld16s(wr[q], wb, woff[q]);
#pragma unroll
      for (int q = 0; q < NXL; q++) gld16s(xr[q], xb, xoff[q]);
    };
    auto sstore = [&](u32x4 (&wr)[NWL], u32x4 (&xr)[NXL], int st) {
      bf16_t* Ws = (bf16_t*)(smem + st * STAGE);
      bf16_t* Xs = Ws + 128 * 72;
#pragma unroll
      for (int q = 0; q < NWL; q++) *(u32x4*)(Ws + (lrow + RSTEP * q) * 72 + lcol) = wr[q];
#pragma unroll
      for (int q = 0; q < NXL; q++) *(u32x4*)(Xs + (lrow + RSTEP * q) * 72 + lcol) = xr[q];
    };
    const bool wact = __builtin_amdgcn_readfirstlane(m0 + wm * 64) < Mrows;
    auto compute = [&](int st) {
      if (!wact) return;
      const bf16_t* Ws = (const bf16_t*)(smem + st * STAGE);
      const bf16_t* Xs = Ws + 128 * 72;
      const bf16_t* ap = Ws + (wn * 64 + (lane & 31)) * 72 + (lane >> 5) * 8;
      const bf16_t* bp = Xs + (wm * 64 + (lane & 31)) * 72 + (lane >> 5) * 8;
      bf16x8 a0 = *(const bf16x8*)(ap), a1 = *(const bf16x8*)(ap + 32 * 72);
      bf16x8 b0 = *(const bf16x8*)(bp), b1 = *(const bf16x8*)(bp + 32 * 72);
#pragma unroll
      for (int kk = 0; kk < 4; kk++) {
        bf16x8 na0, na1, nb0, nb1;
        if (kk < 3) {
          na0 = *(const bf16x8*)(ap + (kk + 1) * 16); na1 = *(const bf16x8*)(ap + 32 * 72 + (kk + 1) * 16);
          nb0 = *(const bf16x8*)(bp + (kk + 1) * 16); nb1 = *(const bf16x8*)(bp + 32 * 72 + (kk + 1) * 16);
        }
        acc[0][0] = __builtin_amdgcn_mfma_f32_32x32x16_bf16(a0, b0, acc[0][0], 0, 0, 0);
        acc[0][1] = __builtin_amdgcn_mfma_f32_32x32x16_bf16(a0, b1, acc[0][1], 0, 0, 0);
        acc[1][0] = __builtin_amdgcn_mfma_f32_32x32x16_bf16(a1, b0, acc[1][0], 0, 0, 0);
        acc[1][1] = __builtin_amdgcn_mfma_f32_32x32x16_bf16(a1, b1, acc[1][1], 0, 0, 0);
        if (kk < 3) { a0 = na0; a1 = na1; b0 = nb0; b1 = nb1; }
      }
    };
    auto kstep = [&](u32x4 (&wr)[NWL], u32x4 (&xr)[NXL], int kt) {
      compute(kt & 1);
      if (kt + 1 < KT) {
        if (kt + 2 < KT) asm volatile("s_waitcnt vmcnt(%0)" ::"n"(NWL + NXL) : "memory");
        else GLD_WAIT();
        sstore(wr, xr, (kt + 1) & 1);
        if (kt + 3 < KT) gload(wr, xr, kt + 3);
      }
      __syncthreads();
    };
    gload(w0r, x0r, 0);
    GLD_WAIT();
    sstore(w0r, x0r, 0);
    if (KT > 1) gload(w1r, x1r, 1);
    if (KT > 2) gload(w0r, x0r, 2);
    __syncthreads();
    for (int kt = 0; kt < KT; kt += 2) {
      kstep(w1r, x1r, kt);
      if (kt + 1 < KT) kstep(w0r, x0r, kt + 1);
    }
    const int hh = lane >> 5;
    float* cst_s = (float*)(smem_all + 2 * STAGE);
    if (EPI == EPI_MERGE) {
      if (tid < 384) {
        const int a = tid >> 7, cl = tid & 127, c = n0 + cl;
        cst_s[tid] = a == 0 ? p.out_norm[c & 127] : (a == 1 ? p.ln_g[c] : p.ln_b[c]);
      }
      __syncthreads();
    }
#pragma unroll
    for (int j = 0; j < 2; j++) {
      if (__builtin_amdgcn_readfirstlane(m0 + wm * 64 + j * 32) >= Mrows) continue;
      const int m = m0 + wm * 64 + j * 32 + (lane & 31);
      const bool mv = (m < Mrows) && !dry;
      const int mc = mv ? m : Mrows - 1;
      if (EPI == EPI_SWIGLU) {
        const float rs = rsqrtf(ss[(half ? 2 : 0) * MTOT + mc] * (1.f / DM) + EPS);
        bf16_t* act = (bf16_t*)(p.ws + W_ACT);
#pragma unroll
        for (int g = 0; g < 4; g++) {
          float o[4];
#pragma unroll
          for (int e = 0; e < 4; e++) {
            float gt = acc[0][j][4 * g + e] * rs, up = acc[1][j][4 * g + e] * rs;
            o[e] = siluf_(gt) * up;
          }
          int col = nt * 64 + wn * 32 + 8 * g + 4 * hh;
          if (mv) *(uint2*)(act + (size_t)m * DFF + col) = make_uint2(pack2(o[0], o[1]), pack2(o[2], o[3]));
        }
      } else if (EPI == EPI_DOWN1 || EPI == EPI_WOUT || EPI == EPI_DOWN2) {
        const int mg = (EPI == EPI_WOUT) ? half * MH + mc : mc;
        float ssq = 0.f;
        const float* h0 = (EPI == EPI_DOWN1) ? h0row(p, mg) : nullptr;
        float* h3 = (float*)(p.ws + W_H3);
        float4 rf[2][4];
        uint2 rb[2][4];
#pragma unroll
        for (int i = 0; i < 2; i++)
#pragma unroll
          for (int g = 0; g < 4; g++) {
            const int n = n0 + wn * 64 + i * 32 + 8 * g + 4 * hh;
            if (EPI == EPI_DOWN1) rf[i][g] = *(const float4*)(h0 + n);
            else rb[i][g] = *(const uint2*)(hb + (size_t)mg * DM + n);
          }
#pragma unroll
        for (int i = 0; i < 2; i++)
#pragma unroll
          for (int g = 0; g < 4; g++) {
            const int n = n0 + wn * 64 + i * 32 + 8 * g + 4 * hh;
            float o[4];
            if (EPI == EPI_DOWN1) {
              const float4 r = rf[i][g];
              o[0] = r.x + 0.5f * acc[i][j][4 * g + 0];
              o[1] = r.y + 0.5f * acc[i][j][4 * g + 1];
              o[2] = r.z + 0.5f * acc[i][j][4 * g + 2];
              o[3] = r.w + 0.5f * acc[i][j][4 * g + 3];
            } else {
              const uint2 r = rb[i][g];
              const float sc = (EPI == EPI_WOUT) ? 1.f : 0.5f;
              o[0] = bf2f(r.x & 0xffff) + sc * acc[i][j][4 * g + 0];
              o[1] = bf2f(r.x >> 16) + sc * acc[i][j][4 * g + 1];
              o[2] = bf2f(r.y & 0xffff) + sc * acc[i][j][4 * g + 2];
              o[3] = bf2f(r.y >> 16) + sc * acc[i][j][4 * g + 3];
            }
            if (EPI == EPI_DOWN2) {
              ssq += o[0] * o[0] + o[1] * o[1] + o[2] * o[2] + o[3] * o[3];
              if (mv) *(float4*)(h3 + (size_t)mg * DM + n) = make_float4(o[0], o[1], o[2], o[3]);
            } else {
              uint32_t lo = pack2(o[0], o[1]), hi = pack2(o[2], o[3]);
              float q0 = bf2f(lo & 0xffff), q1 = bf2f(lo >> 16), q2 = bf2f(hi & 0xffff), q3 = bf2f(hi >> 16);
              ssq += q0 * q0 + q1 * q1 + q2 * q2 + q3 * q3;
              if (mv) *(uint2*)(hb + (size_t)mg * DM + n) = make_uint2(lo, hi);
            }
          }
        ssq += __shfl_xor(ssq, 32);
        const int which = (EPI == EPI_DOWN1) ? 1 : (EPI == EPI_WOUT ? 2 : 3);
        if (mv && hh == 0) atomicAdd(&ss[which * MTOT + mg], ssq);
      } else if (EPI == EPI_WIN) {
        const int mg = half * MH + mc;
        const float rs = rsqrtf(ss[1 * MTOT + mg] * (1.f / DM) + EPS);
        bf16_t* z = (bf16_t*)(p.ws + W_Z);
        float* ba = (float*)(p.ws + W_BA);
#pragma unroll
        for (int i = 0; i < 2; i++)
#pragma unroll
          for (int g = 0; g < 4; g++) {
            const int n = n0 + wn * 64 + i * 32 + 8 * g + 4 * hh;
            float o0 = acc[i][j][4 * g + 0] * rs, o1 = acc[i][j][4 * g + 1] * rs, o2 = acc[i][j][4 * g + 2] * rs,
                  o3 = acc[i][j][4 * g + 3] * rs;
            if (mv && n < NIN) {
              *(uint2*)(z + (size_t)m * NIN + n) = make_uint2(pack2(o0, o1), pack2(o2, o3));
              if (n >= 4096 && n < 4112) *(float4*)(ba + (size_t)m * 16 + (n - 4096)) = make_float4(o0, o1, o2, o3);
            }
          }
      } else if (EPI == EPI_MERGE) {
        bf16_t* z = (bf16_t*)(p.ws + W_Z);
        const bf16_t* oa = (const bf16_t*)(p.ws + W_OA);
        const float* ost = (const float*)(p.ws + W_OST);
        const bf16_t* yb = (const bf16_t*)(p.ws + W_YB);
        const float* yst = (const float*)(p.ws + W_YST);
        const bf16_t* bon = (const bf16_t*)(p.ws + W_BON);
        const int cw0 = n0 + wn * 64;
        const float4 os = *(const float4*)(ost + ((size_t)mc * 8 + (cw0 >> 7)) * 4);
        const float* ys = yst + ((size_t)mc * 16 + (cw0 >> 6)) * 8;
        const float4 y0 = *(const float4*)ys, y1 = *(const float4*)(ys + 4);
        const float rstd_a = rsqrtf((os.x + os.y + os.z + os.w) * (1.f / 128.f) + EPS);
        const float sy = y0.x + y0.z + y1.x + y1.z, sy2 = y0.y + y0.w + y1.y + y1.w;
        const float mean = sy * (1.f / 64.f);
        const float var = fmaxf(sy2 * (1.f / 64.f) - mean * mean, 0.f);
        const float rstd_b = rsqrtf(var + 64e-5f);
#pragma unroll
        for (int i = 0; i < 2; i++) {
          uint2 L[4][6];
#pragma unroll
          for (int g = 0; g < 4; g++) {
            const int c = cw0 + i * 32 + 8 * g + 4 * hh;
            L[g][0] = *(const uint2*)(oa + (size_t)mc * DM + c);
            L[g][1] = *(const uint2*)(yb + (size_t)mc * DM + c);
            L[g][2] = *(const uint2*)(bon + (size_t)mc * DM + c);
            L[g][3] = *(const uint2*)(z + (size_t)mc * NIN + 3072 + c);
            L[g][4] = *(const uint2*)(z + (size_t)mc * NIN + 7472 + c);
            L[g][5] = *(const uint2*)(z + (size_t)mc * NIN + 8496 + c);
          }
#pragma unroll
          for (int g = 0; g < 4; g++) {
            const int c = cw0 + i * 32 + 8 * g + 4 * hh;
            const int cl = c - n0;
            const float4 on4 = *(const float4*)(cst_s + cl), lg4 = *(const float4*)(cst_s + 128 + cl),
                         lb4 = *(const float4*)(cst_s + 256 + cl);
            const float onv[4] = {on4.x, on4.y, on4.z, on4.w}, lgv[4] = {lg4.x, lg4.y, lg4.z, lg4.w},
                        lbv[4] = {lb4.x, lb4.y, lb4.z, lb4.w};
            float o[4];
#pragma unroll
            for (int e = 0; e < 4; e++) {
              auto sel = [&](uint2 v) { uint32_t w = (e < 2) ? v.x : v.y; return bf2f((e & 1) ? (w >> 16) : (w & 0xffff)); };
              float oav = sel(L[g][0]) * rstd_a * onv[e] * siluf_(sel(L[g][3]));
              float yn = (sel(L[g][1]) - mean) * rstd_b * lgv[e] + lbv[e] + sel(L[g][2]);
              float obv = yn * acc[i][j][4 * g + e];
              o[e] = sigmoidf_(sel(L[g][4])) * oav + sigmoidf_(sel(L[g][5])) * obv;
            }
            if (mv) *(uint2*)((bf16_t*)oa + (size_t)m * DM + c) = make_uint2(pack2(o[0], o[1]), pack2(o[2], o[3]));
          }
        }
      }
    }
    if (EPI == EPI_MERGE) __syncthreads();
  }
}


template <int EPI>
__device__ __forceinline__ void gemm_big(const P& p, char* smem, const bf16_t* __restrict__ X, int ldx, int Mrows,
                                         const bf16_t* __restrict__ W, int K, int Ntiles, int half) {
  constexpr int STAGE = 512 * 72 * 2;
  const int tid = otid(), lane = tid & 63, wv = tid >> 6;
  const int wn = wv & 1, wm = wv >> 1;
  const int Mtiles = (Mrows + 255) / 256;
  const int total = Mtiles * Ntiles;
  const int KT = K / 64;
  const int lrow = tid >> 3, lcol = (tid & 7) * 8;
  float* ss = (float*)(p.ws + W_SS);
  const int G8 = (gridDim.x & 7) == 0 ? (int)(gridDim.x >> 3) : 0;
  const int pb = G8 ? (int)((blockIdx.x & 7) * G8 + (blockIdx.x >> 3)) : (int)blockIdx.x;
  const int mfull = (Mtiles >> 2) << 2, nfull = mfull * Ntiles, mrem = Mtiles - mfull;
  for (int tile = pb; tile < total; tile += gridDim.x) {
    int mt, nt;
    if (tile < nfull) {
      const int rg = tile / (4 * Ntiles), rem = tile - rg * 4 * Ntiles;
      nt = rem >> 2;
      mt = rg * 4 + (rem & 3);
    } else {
      const int rem = tile - nfull;
      nt = rem / mrem;
      mt = mfull + (rem - nt * mrem);
    }
    const int m0 = mt * 256, n0 = nt * 256;
    u32x4 wr[4], xr[4];
    f32x16 acc[4][2];
#pragma unroll
    for (int i = 0; i < 4; i++)
#pragma unroll
      for (int j = 0; j < 2; j++)
#pragma unroll
        for (int r = 0; r < 16; r++) acc[i][j][r] = 0.f;
    uint32_t woff[4], xoff[4];
#pragma unroll
    for (int q = 0; q < 4; q++) {
      woff[q] = (uint32_t)(((size_t)(n0 + lrow + 64 * q) * K + lcol) * 2);
      int row = m0 + lrow + 64 * q;
      row = row < Mrows ? row : Mrows - 1;
      xoff[q] = (uint32_t)(((size_t)row * ldx + lcol) * 2);
    }
    auto gload = [&](int kt) {
      const bf16_t* wb = W + kt * 64;
      const bf16_t* xb = X + kt * 64;
#pragma unroll
      for (int q = 0; q < 4; q++) gld16s(wr[q], wb, woff[q]);
#pragma unroll
      for (int q = 0; q < 4; q++) gld16s(xr[q], xb, xoff[q]);
    };
    auto sstore = [&](int st) {
      bf16_t* Ws = (bf16_t*)(smem + st * STAGE);
      bf16_t* Xs = Ws + 256 * 72;
#pragma unroll
      for (int q = 0; q < 4; q++) *(u32x4*)(Ws + (lrow + 64 * q) * 72 + lcol) = wr[q];
#pragma unroll
      for (int q = 0; q < 4; q++) *(u32x4*)(Xs + (lrow + 64 * q) * 72 + lcol) = xr[q];
    };
    const bool wact = __builtin_amdgcn_readfirstlane(m0 + wm * 64) < Mrows;
    gload(0);
    GLD_WAIT();
    sstore(0);
    if (KT > 1) gload(1);
    __syncthreads();
    for (int kt = 0; kt < KT; kt++) {
      if (wact) {
        const bf16_t* Ws = (const bf16_t*)(smem + (kt & 1) * STAGE);
        const bf16_t* Xs = Ws + 256 * 72;
        const bf16_t* ap = Ws + (wn * 128 + (lane & 31)) * 72 + (lane >> 5) * 8;
        const bf16_t* bp = Xs + (wm * 64 + (lane & 31)) * 72 + (lane >> 5) * 8;
        bf16x8 b0 = *(const bf16x8*)(bp), b1 = *(const bf16x8*)(bp + 32 * 72);
        bf16x8 a0 = *(const bf16x8*)(ap), a1 = *(const bf16x8*)(ap + 32 * 72), a2 = *(const bf16x8*)(ap + 64 * 72),
               a3 = *(const bf16x8*)(ap + 96 * 72);
#pragma unroll
        for (int kk = 0; kk < 4; kk++) {
          bf16x8 nb0, nb1, na0, na1, na2, na3;
          if (kk < 3) {
            nb0 = *(const bf16x8*)(bp + (kk + 1) * 16); nb1 = *(const bf16x8*)(bp + 32 * 72 + (kk + 1) * 16);
            na0 = *(const bf16x8*)(ap + (kk + 1) * 16); na1 = *(const bf16x8*)(ap + 32 * 72 + (kk + 1) * 16);
            na2 = *(const bf16x8*)(ap + 64 * 72 + (kk + 1) * 16); na3 = *(const bf16x8*)(ap + 96 * 72 + (kk + 1) * 16);
          }
          acc[0][0] = __builtin_amdgcn_mfma_f32_32x32x16_bf16(a0, b0, acc[0][0], 0, 0, 0);
          acc[0][1] = __builtin_amdgcn_mfma_f32_32x32x16_bf16(a0, b1, acc[0][1], 0, 0, 0);
          acc[1][0] = __builtin_amdgcn_mfma_f32_32x32x16_bf16(a1, b0, acc[1][0], 0, 0, 0);
          acc[1][1] = __builtin_amdgcn_mfma_f32_32x32x16_bf16(a1, b1, acc[1][1], 0, 0, 0);
          acc[2][0] = __builtin_amdgcn_mfma_f32_32x32x16_bf16(a2, b0, acc[2][0], 0, 0, 0);
          acc[2][1] = __builtin_amdgcn_mfma_f32_32x32x16_bf16(a2, b1, acc[2][1], 0, 0, 0);
          acc[3][0] = __builtin_amdgcn_mfma_f32_32x32x16_bf16(a3, b0, acc[3][0], 0, 0, 0);
          acc[3][1] = __builtin_amdgcn_mfma_f32_32x32x16_bf16(a3, b1, acc[3][1], 0, 0, 0);
          if (kk < 3) { b0 = nb0; b1 = nb1; a0 = na0; a1 = na1; a2 = na2; a3 = na3; }
        }
      }
      if (kt + 1 < KT) {
        GLD_WAIT();
        sstore((kt + 1) & 1);
        if (kt + 2 < KT) gload(kt + 2);
      }
      __syncthreads();
    }
    const int hh = lane >> 5;
#pragma unroll
    for (int j = 0; j < 2; j++) {
      if (__builtin_amdgcn_readfirstlane(m0 + wm * 64 + j * 32) >= Mrows) continue;
      const int m = m0 + wm * 64 + j * 32 + (lane & 31);
      const bool mv = m < Mrows;
      const int mc = mv ? m : Mrows - 1;
      if (EPI == EPI_SWIGLU) {
        const float rs = rsqrtf(ss[(half ? 2 : 0) * MTOT + mc] * (1.f / DM) + EPS);
        bf16_t* act = (bf16_t*)(p.ws + W_ACT);
#pragma unroll
        for (int pr = 0; pr < 2; pr++)
#pragma unroll
          for (int g = 0; g < 4; g++) {
            float o[4];
#pragma unroll
            for (int e = 0; e < 4; e++) {
              float gt = acc[2 * pr][j][4 * g + e] * rs, up = acc[2 * pr + 1][j][4 * g + e] * rs;
              o[e] = siluf_(gt) * up;
            }
            int col = (2 * nt + wn) * 64 + pr * 32 + 8 * g + 4 * hh;
            if (mv) *(uint2*)(act + (size_t)m * DFF + col) = make_uint2(pack2(o[0], o[1]), pack2(o[2], o[3]));
          }
      } else {
        const int mg = half * MH + mc;
        const float rs = rsqrtf(ss[1 * MTOT + mg] * (1.f / DM) + EPS);
        bf16_t* z = (bf16_t*)(p.ws + W_Z);
        float* ba = (float*)(p.ws + W_BA);
#pragma unroll
        for (int i = 0; i < 4; i++)
#pragma unroll
          for (int g = 0; g < 4; g++) {
            const int n = n0 + wn * 128 + i * 32 + 8 * g + 4 * hh;
            float o0 = acc[i][j][4 * g + 0] * rs, o1 = acc[i][j][4 * g + 1] * rs, o2 = acc[i][j][4 * g + 2] * rs,
                  o3 = acc[i][j][4 * g + 3] * rs;
            if (mv && n < NIN) {
              *(uint2*)(z + (size_t)m * NIN + n) = make_uint2(pack2(o0, o1), pack2(o2, o3));
              if (n >= 4096 && n < 4112) *(float4*)(ba + (size_t)m * 16 + (n - 4096)) = make_float4(o0, o1, o2, o3);
            }
          }
      }
    }
  }
}

DEV void conv8(const bf16_t* __restrict__ Zb, int t, int zc, const float* __restrict__ cw, float (&o)[8]) {
#pragma unroll
  for (int e = 0; e < 8; e++) o[e] = 0.f;
#pragma unroll
  for (int j = 0; j < 4; j++) {
    int tt = t - 3 + j;
    if (tt >= 0) {
      uint4 raw = *(const uint4*)(Zb + (size_t)tt * NIN + zc);
      float4 w0 = *(const float4*)(cw + j * 3072 + zc), w1 = *(const float4*)(cw + j * 3072 + zc + 4);
      o[0] += bf2f(raw.x & 0xffff) * w0.x; o[1] += bf2f(raw.x >> 16) * w0.y;
      o[2] += bf2f(raw.y & 0xffff) * w0.z; o[3] += bf2f(raw.y >> 16) * w0.w;
      o[4] += bf2f(raw.z & 0xffff) * w1.x; o[5] += bf2f(raw.z >> 16) * w1.y;
      o[6] += bf2f(raw.w & 0xffff) * w1.z; o[7] += bf2f(raw.w >> 16) * w1.w;
    }
  }
#pragma unroll
  for (int e = 0; e < 8; e++) o[e] = siluf_(o[e]);
}

__device__ __forceinline__ void phase4(const P& p, char* smem) {
  const int tid = otid(), lane = tid & 63, wv = tid >> 6;
  char* gs = smem + wv * 18432;
  float* g_s = (float*)gs;
  float* be_s = g_s + 64;
  bf16_t* kn = (bf16_t*)(gs + 512);
  float* Mf = (float*)(gs + 512);
  const bf16_t* z = (const bf16_t*)(p.ws + W_Z);
  const float* ba = (const float*)(p.ws + W_BA);
  float* GB = (float*)(p.ws + W_GB);
  float* BB = (float*)(p.ws + W_BB);
  bf16_t* TTb = (bf16_t*)(p.ws + W_TT);
  for (int task = blockIdx.x * 8 + wv; task < 16 * NCHUNK; task += gridDim.x * 8) {
    const int unit = task / NCHUNK, n = task - unit * NCHUNK;
    const int bl = unit >> 3, h = unit & 7;
    const int tbase = n * 64 - 48;
    const bf16_t* Zb = z + (size_t)bl * TT * NIN;
    {
      int t = tbase + lane;
      float g = 0.f, be = 0.f;
      if (t >= 0) {
        size_t mrow = (size_t)bl * TT + t;
        float bp = ba[mrow * 16 + h], al = ba[mrow * 16 + 8 + h];
        g = -__expf(p.log_rate[h]) * softplusf_(al + p.dt_bias[h]);
        be = sigmoidf_(bp);
      }
#pragma unroll
      for (int d = 1; d < 64; d <<= 1) {
        float tq = __shfl_up(g, d);
        if (lane >= d) g += tq;
      }
      g_s[lane] = g;
      be_s[lane] = be;
      GB[(size_t)task * 64 + lane] = g;
      BB[(size_t)task * 64 + lane] = be;
    }
#pragma unroll 4
    for (int q = 0; q < 16; q++) {
      int id = lane + 64 * q;
      int row = id >> 4, cgp = id & 15;
      float o[8];
      conv8(Zb, tbase + row, 1024 + h * 128 + cgp * 8, p.conv_w, o);
      float sq = 0.f;
#pragma unroll
      for (int e = 0; e < 8; e++) sq += o[e] * o[e];
      sq = red16(sq);
      float sc = rsqrtf(sq + 1e-6f);
      *(uint4*)(kn + row * 136 + cgp * 8) =
          make_uint4(pack2(o[0] * sc, o[1] * sc), pack2(o[2] * sc, o[3] * sc), pack2(o[4] * sc, o[5] * sc),
                     pack2(o[6] * sc, o[7] * sc));
    }
    WAVE_FENCE();
    f32x16 kk[4];
#pragma unroll
    for (int tq = 0; tq < 4; tq++) {
#pragma unroll
      for (int r = 0; r < 16; r++) kk[tq][r] = 0.f;
      kk[tq] = mm32(kn + (tq >> 1) * 32 * 136, 136, kn + (tq & 1) * 32 * 136, 136, 128, kk[tq], lane);
    }
    WAVE_FENCE();
#pragma unroll
    for (int tq = 0; tq < 4; tq++) {
#pragma unroll
      for (int r = 0; r < 16; r++) {
        int c = (tq >> 1) * 32 + rowof(r, lane), sx = (tq & 1) * 32 + (lane & 31);
        float v = (c > sx) ? be_s[c] * kk[tq][r] * __expf(g_s[c] - g_s[sx]) : 0.f;
        Mf[c * 68 + sx] = v;
      }
    }
    WAVE_FENCE();
    bf16_t* Tg = TTb + (size_t)task * 4096;
    {
      float x[64];
#pragma unroll
      for (int c = 0; c < 64; c++) x[c] = 0.f;
#pragma unroll
      for (int c = 0; c < 64; c++) {
        float a0 = (lane == c) ? 1.f : 0.f, a1 = 0.f, a2 = 0.f, a3 = 0.f;
#pragma unroll
        for (int s4 = 0; s4 < (c + 3) / 4; s4++) {
          const float4 mv = *(const float4*)(Mf + c * 68 + s4 * 4);
          a0 -= mv.x * x[s4 * 4 + 0];
          a1 -= mv.y * x[s4 * 4 + 1];
          a2 -= mv.z * x[s4 * 4 + 2];
          a3 -= mv.w * x[s4 * 4 + 3];
        }
        x[c] = (a0 + a1) + (a2 + a3);
        Tg[c * 64 + lane] = f2bf(x[c]);
      }
    }
    WAVE_FENCE();
  }
  bf16_t* sg = (bf16_t*)(p.ws + W_SG);
  for (int idx = blockIdx.x * 512 + tid; idx < MH * 24; idx += gridDim.x * 512) {
    const int m = idx / 24, jg = idx - m * 24;
    uint4 outv = make_uint4(0, 0, 0, 0);
    if (jg < 20) {
      const int t = m % TT;
      const bf16_t* src = z + (size_t)m * NIN + ZRW + 3200 + jg * 8;
      const uint4 cu = *(const uint4*)src;
      uint4 pr = make_uint4(0, 0, 0, 0);
      if (t > 0) pr = *(const uint4*)(src - NIN);
      const float4 m0 = *(const float4*)(p.mu + 3200 + jg * 8), m1 = *(const float4*)(p.mu + 3200 + jg * 8 + 4);
      const float mm[8] = {m0.x, m0.y, m0.z, m0.w, m1.x, m1.y, m1.z, m1.w};
      const uint32_t cw[4] = {cu.x, cu.y, cu.z, cu.w}, pw[4] = {pr.x, pr.y, pr.z, pr.w};
      float v[8];
#pragma unroll
      for (int e = 0; e < 8; e++) {
        float c = bf2f((e & 1) ? (cw[e >> 1] >> 16) : (cw[e >> 1] & 0xffff));
        float q = bf2f((e & 1) ? (pw[e >> 1] >> 16) : (pw[e >> 1] & 0xffff));
        v[e] = sigmoidf_(c + (q - c) * mm[e]);
      }
      outv = make_uint4(pack2(v[0], v[1]), pack2(v[2], v[3]), pack2(v[4], v[5]), pack2(v[6], v[7]));
    }
    *(uint4*)(sg + (size_t)m * 192 + jg * 8) = outv;
  }
  bf16_t* xwa = (bf16_t*)(p.ws + W_XWA);
  for (int idx = blockIdx.x * 512 + tid; idx < MH * 16; idx += gridDim.x * 512) {
    const int m = idx >> 4, jg = idx & 15;
    const int t = m % TT;
    const bf16_t* src = z + (size_t)m * NIN + ZRW + 3072 + jg * 8;
    const uint4 cu = *(const uint4*)src;
    uint4 pr = make_uint4(0, 0, 0, 0);
    if (t > 0) pr = *(const uint4*)(src - NIN);
    const float4 m0 = *(const float4*)(p.mu + 3072 + jg * 8), m1 = *(const float4*)(p.mu + 3072 + jg * 8 + 4);
    const float mm[8] = {m0.x, m0.y, m0.z, m0.w, m1.x, m1.y, m1.z, m1.w};
    const uint32_t cw[4] = {cu.x, cu.y, cu.z, cu.w}, pw[4] = {pr.x, pr.y, pr.z, pr.w};
    float v[8];
#pragma unroll
    for (int e = 0; e < 8; e++) {
      float c = bf2f((e & 1) ? (cw[e >> 1] >> 16) : (cw[e >> 1] & 0xffff));
      float q = bf2f((e & 1) ? (pw[e >> 1] >> 16) : (pw[e >> 1] & 0xffff));
      float x = c + (q - c) * mm[e];
      if (jg < 8) { float ex = __expf(2.f * x); x = 1.f - 2.f * rcpf_(ex + 1.f); }
      v[e] = x;
    }
    *(uint4*)(xwa + (size_t)m * 128 + jg * 8) = make_uint4(pack2(v[0], v[1]), pack2(v[2], v[3]), pack2(v[4], v[5]), pack2(v[6], v[7]));
  }
}

constexpr int RLD = 68;
constexpr int RW_NC = (TT + 31) / 32;
constexpr int RW_BUF = (5 * 32 * RLD + 32 * 16 + 32) * 4;
DEV int rw_rel(int ch, int h, int rq) {
  return ch < 8 ? h * 64 + ch * 8
       : ch < 16 ? 1024 + h * 64 + (ch - 8) * 8
       : ch < 24 ? 3072 + (ch - 16) * 8
       : ch < 32 ? 3136 + (ch - 24) * 8
                 : 2048 + h * 64 + rq * 16 + (ch - 32) * 8;
}
DEV float wave_sum_bcast(float v) {
  v = red16(v);
  float r0 = __int_as_float(__builtin_amdgcn_readlane(__float_as_int(v), 0));
  float r1 = __int_as_float(__builtin_amdgcn_readlane(__float_as_int(v), 16));
  float r2 = __int_as_float(__builtin_amdgcn_readlane(__float_as_int(v), 32));
  float r3 = __int_as_float(__builtin_amdgcn_readlane(__float_as_int(v), 48));
  return (r0 + r1) + (r2 + r3);
}
__device__ __forceinline__ void rwkv_block(const P& p, char* smem, int unit, int rq) {
  const int tid = otid(), lane = tid & 63;
  const int wv = __builtin_amdgcn_readfirstlane(tid >> 6);
  const int bl = unit >> 4, h = unit & 15;
  bf16_t* wupT = (bf16_t*)smem;
  bf16_t* aupT = wupT + 64 * 72;
  bf16_t* Xw = aupT + 64 * 72;
  bf16_t* Xa = Xw + 32 * 72;
  bf16_t* raw_all = Xa + 32 * 72;
  float* mu_s = (float*)(raw_all + 4 * 9 * 272);
  float* y_all = mu_s + 272;
  char* obuf = (char*)(y_all + 2 * 512);
  for (int e = tid; e < 4096; e += 512) {
    int j = e >> 6, c = e & 63;
    wupT[c * 72 + j] = f2bf(p.w_up[(size_t)j * DM + h * 64 + c]);
    aupT[c * 72 + j] = f2bf(p.a_up[(size_t)j * DM + h * 64 + c]);
  }
  for (int e = tid; e < 2 * 32 * 72; e += 512) Xw[e] = 0;
  if (tid < 272) mu_s[tid] = p.mu[rw_rel(tid >> 3, h, rq) + (tid & 7)];
  const bf16_t* Zb = (const bf16_t*)(p.ws + W_Z) + (size_t)bl * TT * NIN + ZRW;
  bf16_t* YB = (bf16_t*)(p.ws + W_YB);
  bf16_t* BON = (bf16_t*)(p.ws + W_BON);
  float* YST = (float*)(p.ws + W_YST);
  __syncthreads();
  if (wv >= 4) {
    const int pw = wv - 4;
    bf16_t* raw_s = raw_all + pw * 9 * 144;
    const bf16_t* XWA = (const bf16_t*)(p.ws + W_XWA) + (size_t)bl * TT * 128;
    uint4 pre[5];
    auto prefetch = [&](int t0) {
#pragma unroll
      for (int q = 0; q < 5; q++) {
        int item = lane + 64 * q;
        pre[q] = make_uint4(0, 0, 0, 0);
        if (item < 162) {
          int row = item / 18, c18 = item - row * 18;
          int t = t0 + pw * 8 - 1 + row;
          if (t >= 0 && t < TT) pre[q] = *(const uint4*)(Zb + (size_t)t * NIN + rw_rel(c18 < 16 ? c18 : 16 + c18, h, rq));
        } else if (item < 162 + 128) {
          int j = item - 162;
          int t = t0 + pw * 8 + (j >> 4);
          if (t < TT) pre[q] = *(const uint4*)(XWA + (size_t)t * 128 + (j & 15) * 8);
        }
      }
    };
    prefetch(0);
    float cst[5][8];
#pragma unroll
    for (int e = 0; e < 8; e++) {
      const int ch = h * 64 + (lane & 7) * 8 + e;
      cst[0][e] = p.w0[ch]; cst[1][e] = p.a0[ch]; cst[2][e] = p.k_k[ch]; cst[3][e] = p.k_a[ch]; cst[4][e] = p.r_k[ch];
    }
    for (int i = 0; i < RW_NC + 2; i++) {
      float* bufp = (float*)(obuf + (i & 1) * RW_BUF);
      float* rs_s = bufp;
      float* ks_s = rs_s + 32 * RLD;
      float* w_s = ks_s + 32 * RLD;
      float* a_s = w_s + 32 * RLD;
      float* na_s = a_s + 32 * RLD;
      float* vs_s = na_s + 32 * RLD;
      float* rk_s = vs_s + 512;
      if (i >= 2) {
        const float* y_s = y_all + (i & 1) * 512;
        const int t0o = (i - 2) * 32;
#pragma unroll
        for (int q = 0; q < 2; q++) {
          int item = lane + 64 * q;
          int tt = pw * 8 + (item >> 4), rl = item & 15;
          int t = t0o + tt;
          float y = y_s[tt * 16 + rl];
          float sy = red16(y), sy2 = red16(y * y);
          if (t < TT) {
            size_t mrow = (size_t)bl * TT + t;
            int col = h * 64 + rq * 16 + rl;
            YB[mrow * DM + col] = f2bf(y);
            BON[mrow * DM + col] = f2bf(rk_s[tt] * vs_s[tt * 16 + rl]);
            if (rl == 0) {
              float* d = YST + ((mrow * 16 + h) * 4 + rq) * 2;
              d[0] = sy;
              d[1] = sy2;
            }
          }
        }
        WAVE_FENCE();
      }
      if (i < RW_NC) {
        const int t0 = i * 32;
#pragma unroll
        for (int q = 0; q < 5; q++) {
          int item = lane + 64 * q;
          if (item < 162) {
            int row = item / 18, c18 = item - row * 18;
            *(uint4*)(raw_s + row * 144 + c18 * 8) = pre[q];
          } else if (item < 162 + 128) {
            int j = item - 162;
            int c16 = j & 15;
            *(uint4*)((c16 < 8 ? Xw : Xa) + (pw * 8 + (j >> 4)) * 72 + (c16 & 7) * 8) = pre[q];
          }
        }
        WAVE_FENCE();
        prefetch(t0 + 32);
        {
          auto shift8 = [&](int tl, int c18, int chm, float (&v)[8]) {
            uint4 cu = *(const uint4*)(raw_s + (tl + 1) * 144 + c18 * 8);
            uint4 pr = *(const uint4*)(raw_s + tl * 144 + c18 * 8);
            uint32_t cw[4] = {cu.x, cu.y, cu.z, cu.w}, pwd[4] = {pr.x, pr.y, pr.z, pr.w};
            float4 m0 = *(const float4*)(mu_s + chm * 8), m1 = *(const float4*)(mu_s + chm * 8 + 4);
            const float mm[8] = {m0.x, m0.y, m0.z, m0.w, m1.x, m1.y, m1.z, m1.w};
#pragma unroll
            for (int e = 0; e < 8; e++) {
              float c = bf2f((e & 1) ? (cw[e >> 1] >> 16) : (cw[e >> 1] & 0xffff));
              float q = bf2f((e & 1) ? (pwd[e >> 1] >> 16) : (pwd[e >> 1] & 0xffff));
              v[e] = c + (q - c) * mm[e];
            }
          };
          const int tl = lane >> 3, c8 = lane & 7, tt = pw * 8 + tl;
          float v[8];
          shift8(tl, c8, c8, v);
          *(float4*)(rs_s + tt * RLD + c8 * 8) = make_float4(v[0], v[1], v[2], v[3]);
          *(float4*)(rs_s + tt * RLD + c8 * 8 + 4) = make_float4(v[4], v[5], v[6], v[7]);
          shift8(tl, 8 + c8, 8 + c8, v);
          *(float4*)(ks_s + tt * RLD + c8 * 8) = make_float4(v[0], v[1], v[2], v[3]);
          *(float4*)(ks_s + tt * RLD + c8 * 8 + 4) = make_float4(v[4], v[5], v[6], v[7]);
          if (lane < 16) {
            const int tl2 = lane >> 1, c2 = lane & 1;
            shift8(tl2, 16 + c2, 32 + c2, v);
            float* d = vs_s + (pw * 8 + tl2) * 16 + c2 * 8;
            *(float4*)d = make_float4(v[0], v[1], v[2], v[3]);
            *(float4*)(d + 4) = make_float4(v[4], v[5], v[6], v[7]);
          }
        }
        WAVE_FENCE();
#pragma unroll 1
        for (int tile = 0; tile < 4; tile++) {
          const int mat = tile >> 1, ct = tile & 1;
          f32x16 acc;
#pragma unroll
          for (int r = 0; r < 16; r++) acc[r] = 0.f;
          acc = mm32((mat ? aupT : wupT) + ct * 32 * 72, 72, mat ? Xa : Xw, 72, 64, acc, lane);
          const int t = lane & 31;
          if ((t >> 3) == pw) {
#pragma unroll
            for (int g = 0; g < 4; g++) {
              const int c0 = ct * 32 + 8 * g + 4 * (lane >> 5);
              float o[4] = {acc[4 * g], acc[4 * g + 1], acc[4 * g + 2], acc[4 * g + 3]};
              *(float4*)((mat ? a_s : w_s) + t * RLD + c0) = make_float4(o[0], o[1], o[2], o[3]);
            }
          }
        }
        WAVE_FENCE();
        {
          const int tl = lane >> 3, c8 = lane & 7, tt = pw * 8 + tl;
          float* kp_ = ks_s + tt * RLD + c8 * 8;
          float* a_ = a_s + tt * RLD + c8 * 8;
          float* w_ = w_s + tt * RLD + c8 * 8;
          const float* r_ = rs_s + tt * RLD + c8 * 8;
          float* n_ = na_s + tt * RLD + c8 * 8;
          float kv[8], av[8], wv8[8], rv[8];
          *(float4*)&kv[0] = *(const float4*)kp_; *(float4*)&kv[4] = *(const float4*)(kp_ + 4);
          *(float4*)&av[0] = *(const float4*)a_; *(float4*)&av[4] = *(const float4*)(a_ + 4);
          *(float4*)&wv8[0] = *(const float4*)w_; *(float4*)&wv8[4] = *(const float4*)(w_ + 4);
          *(float4*)&rv[0] = *(const float4*)r_; *(float4*)&rv[4] = *(const float4*)(r_ + 4);
          float kk[8], ssq = 0.f, rkp = 0.f;
#pragma unroll
          for (int e = 0; e < 8; e++) {
            av[e] = sigmoidf_(av[e] + cst[1][e]);
            wv8[e] = __expf(-0.6065306597126334f * sigmoidf_(wv8[e] + cst[0][e]));
            kk[e] = kv[e] * cst[2][e];
            ssq += kk[e] * kk[e];
            kv[e] = kv[e] * (1.f + (av[e] - 1.f) * cst[3][e]);
            rkp += rv[e] * kv[e] * cst[4][e];
          }
          ssq += dpp_f<0xB1>(ssq); ssq += dpp_f<0x4E>(ssq); ssq += dpp_f<0x141>(ssq);
          rkp += dpp_f<0xB1>(rkp); rkp += dpp_f<0x4E>(rkp); rkp += dpp_f<0x141>(rkp);
          const float sc = rsqrtf(ssq + 1e-6f);
#pragma unroll
          for (int e = 0; e < 8; e++) { kk[e] *= sc; av[e] *= kk[e]; kk[e] = -kk[e]; }
          *(float4*)n_ = make_float4(kk[0], kk[1], kk[2], kk[3]); *(float4*)(n_ + 4) = make_float4(kk[4], kk[5], kk[6], kk[7]);
          *(float4*)a_ = make_float4(av[0], av[1], av[2], av[3]); *(float4*)(a_ + 4) = make_float4(av[4], av[5], av[6], av[7]);
          *(float4*)kp_ = make_float4(kv[0], kv[1], kv[2], kv[3]); *(float4*)(kp_ + 4) = make_float4(kv[4], kv[5], kv[6], kv[7]);
          *(float4*)w_ = make_float4(wv8[0], wv8[1], wv8[2], wv8[3]); *(float4*)(w_ + 4) = make_float4(wv8[4], wv8[5], wv8[6], wv8[7]);
          if (c8 == 0) rk_s[tt] = rkp;
        }
      }
      __syncthreads();
    }
  } else {
    float s0 = 0.f, s1 = 0.f, s2 = 0.f, s3 = 0.f;
    const int row_l = (tid >> 4) & 15, kq = tid & 15;
    for (int i = 0; i < RW_NC + 2; i++) {
      if (i >= 1 && i <= RW_NC) {
        typedef float f4v __attribute__((ext_vector_type(4)));
        typedef const __attribute__((address_space(3))) float* ldsf;
        typedef __attribute__((address_space(3))) float* ldsfw;
        const float* bufp = (const float*)(obuf + ((i - 1) & 1) * RW_BUF);
        ldsf rs_s = (ldsf)(bufp + kq * 4);
        ldsf ks_s = rs_s + 32 * RLD;
        ldsf w_s = ks_s + 32 * RLD;
        ldsf a_s = w_s + 32 * RLD;
        ldsf na_s = a_s + 32 * RLD;
        ldsf vs_s = (ldsf)(bufp + 5 * 32 * RLD + row_l);
        ldsfw y_s = (ldsfw)(kq == 0 ? (y_all + ((i - 1) & 1) * 512 + row_l) : (float*)(smem + 143808) + tid);
        asm volatile("" : "+v"(rs_s), "+v"(ks_s), "+v"(w_s), "+v"(a_s), "+v"(na_s), "+v"(vs_s), "+v"(y_s));
        typedef float v2f __attribute__((ext_vector_type(2)));
        f4v a4 = *(const __attribute__((address_space(3))) f4v*)(na_s), w4 = *(const __attribute__((address_space(3))) f4v*)(w_s), b4 = *(const __attribute__((address_space(3))) f4v*)(a_s),
               k4 = *(const __attribute__((address_space(3))) f4v*)(ks_s), r4 = *(const __attribute__((address_space(3))) f4v*)(rs_s);
        float vv = vs_s[0];
        v2f s01 = {s0, s1}, s23 = {s2, s3};
#pragma unroll 8
        for (int tt = 0; tt < 32; tt++) {
          const int tn = (tt + 1) & 31;
          f4v a4n = *(const __attribute__((address_space(3))) f4v*)(na_s + tn * RLD), w4n = *(const __attribute__((address_space(3))) f4v*)(w_s + tn * RLD),
                 b4n = *(const __attribute__((address_space(3))) f4v*)(a_s + tn * RLD), k4n = *(const __attribute__((address_space(3))) f4v*)(ks_s + tn * RLD),
                 r4n = *(const __attribute__((address_space(3))) f4v*)(rs_s + tn * RLD);
          float vvn = vs_s[tn * 16];
          const v2f a01 = {a4.x, a4.y}, a23 = {a4.z, a4.w}, w01 = {w4.x, w4.y}, w23 = {w4.z, w4.w};
          const v2f b01 = {b4.x, b4.y}, b23 = {b4.z, b4.w}, k01 = {k4.x, k4.y}, k23 = {k4.z, k4.w};
          const v2f r01 = {r4.x, r4.y}, r23 = {r4.z, r4.w}, vv2 = {vv, vv};
          v2f pd = s01 * a01 + s23 * a23;
          v2f t01 = s01 * w01 + vv2 * k01, t23 = s23 * w23 + vv2 * k23;
          float sa = red16(pd.x + pd.y);
          const v2f sa2 = {sa, sa};
          s01 = t01 + sa2 * b01;
          s23 = t23 + sa2 * b23;
          v2f py = s01 * r01 + s23 * r23;
          float y = red16(py.x + py.y);
          y_s[tt * 16] = y;
          a4 = a4n; w4 = w4n; b4 = b4n; k4 = k4n; r4 = r4n; vv = vvn;
        }
        s0 = s01.x; s1 = s01.y; s2 = s23.x; s3 = s23.y;
      }
      __syncthreads();
    }
  }
  __syncthreads();
}

__device__ __forceinline__ void delta_block(const P& p, char* smem, int unit, int sl) {
  const int tid0 = otid();
  const int bl = unit >> 3, h = unit & 7;
  float* gc_s = (float*)smem;
  float* be_s = gc_s + 64;
  bf16_t* qn = (bf16_t*)(smem + 512);
  bf16_t* kn = qn + 64 * 136;
  bf16_t* wk = kn + 64 * 136;
  bf16_t* knT = wk + 64 * 136;
  bf16_t* ktT = knT + 128 * 72;
  bf16_t* Tb = ktT + 128 * 72;
  bf16_t* Tbg = Tb + 64 * 72;
  bf16_t* attn = Tbg + 64 * 72;
  bf16_t* vT = attn + 64 * 72;
  bf16_t* vnT = vT + 32 * 72;
  bf16_t* ST = vnT + 32 * 72;
  const bf16_t* z = (const bf16_t*)(p.ws + W_Z);
  const bf16_t* Zb = z + (size_t)bl * TT * NIN;
  const float* GB = (const float*)(p.ws + W_GB);
  const float* BB = (const float*)(p.ws + W_BB);
  const bf16_t* TTb = (const bf16_t*)(p.ws + W_TT);
  bf16_t* OA = (bf16_t*)(p.ws + W_OA);
  float* OST = (float*)(p.ws + W_OST);
  float* cw_s = (float*)(ST + 32 * 136);
  bf16_t* o_s = (bf16_t*)(cw_s + 4 * 288);
  for (int e = tid0; e < 32 * 136; e += 512) ST[e] = 0;
  for (int e = tid0; e < 4 * 288; e += 512) {
    int j = e / 288, c = e - j * 288;
    int zc = c < 128 ? h * 128 + c : (c < 256 ? 1024 + h * 128 + (c - 128) : 2048 + h * 128 + sl * 32 + (c - 256));
    cw_s[e] = p.conv_w[j * 3072 + zc];
  }
  uint4 praw[7], vraw[7];
  const int c_role = tid0 >> 8, c_rg = (tid0 & 255) >> 4, c_cgp = tid0 & 15;
  const int c_zc = (c_role ? 1024 : 0) + h * 128 + c_cgp * 8;
  const int v_rg = tid0 >> 2, v_zc = 2048 + h * 128 + sl * 32 + (tid0 & 3) * 8;
  auto prefetch_raw = [&](int n) {
    const int tb = n * 64 - 48;
#pragma unroll
    for (int i = 0; i < 7; i++) {
      int t = tb + 4 * c_rg - 3 + i;
      praw[i] = make_uint4(0, 0, 0, 0);
      if (n < NCHUNK && t >= 0) praw[i] = *(const uint4*)(Zb + (size_t)t * NIN + c_zc);
      int tv = tb + 4 * v_rg - 3 + i;
      vraw[i] = make_uint4(0, 0, 0, 0);
      if (n < NCHUNK && tid0 < 64 && tv >= 0) vraw[i] = *(const uint4*)(Zb + (size_t)tv * NIN + v_zc);
    }
  };
  uint4 Tpre = make_uint4(0, 0, 0, 0);
  float gpre = 0.f, bpre = 0.f;
  auto prefetch_small = [&](int n) {
    if (n < NCHUNK) {
      const size_t task = (size_t)unit * NCHUNK + n;
      Tpre = *(const uint4*)(TTb + task * 4096 + (tid0 >> 3) * 64 + (tid0 & 7) * 8);
      if (tid0 < 64) { gpre = GB[task * 64 + tid0]; bpre = BB[task * 64 + tid0]; }
    }
  };
  auto flush_o = [&](int n) {
    const int c = tid0 >> 3, part = tid0 & 7;
    const int t = n * 64 - 48 + c;
    uint2 raw = *(const uint2*)(o_s + c * 36 + part * 4);
    float a0 = bf2f(raw.x & 0xffff), a1 = bf2f(raw.x >> 16), a2 = bf2f(raw.y & 0xffff), a3 = bf2f(raw.y >> 16);
    float sq = a0 * a0 + a1 * a1 + a2 * a2 + a3 * a3;
    sq += dpp_f<0xB1>(sq); sq += dpp_f<0x4E>(sq); sq += dpp_f<0x141>(sq);
    if (t >= 0) {
      size_t mrow = (size_t)bl * TT + t;
      *(uint2*)(OA + mrow * DM + h * 128 + sl * 32 + part * 4) = raw;
      if (part == 0) OST[(mrow * 8 + h) * 4 + sl] = sq;
    }
  };
  prefetch_raw(0);
  prefetch_small(0);
  f32x16 R;
#pragma unroll
  for (int r = 0; r < 16; r++) R[r] = 0.f;
  __syncthreads();
  for (int n = 0; n < NCHUNK; n++) {
    int tid = tid0;
    asm volatile("" : "+v"(tid));
    int lane = tid & 63, wv = tid >> 6;
    const int task = unit * NCHUNK + n;
    const int tbase = n * 64 - 48;
    if (tid < 64) { gc_s[tid] = gpre; be_s[tid] = bpre; }
    if (n > 0) flush_o(n - 1);
    __syncthreads();
    const float gl = gc_s[63];
    {
      const int cbase = c_role * 128 + c_cgp * 8;
      float cwv[4][8];
#pragma unroll
      for (int j = 0; j < 4; j++) {
        float4 w0 = *(const float4*)(cw_s + j * 288 + cbase), w1 = *(const float4*)(cw_s + j * 288 + cbase + 4);
        cwv[j][0] = w0.x; cwv[j][1] = w0.y; cwv[j][2] = w0.z; cwv[j][3] = w0.w;
        cwv[j][4] = w1.x; cwv[j][5] = w1.y; cwv[j][6] = w1.z; cwv[j][7] = w1.w;
      }
      uint32_t kpk[4][4];
#pragma unroll
      for (int rr = 0; rr < 4; rr++)
#pragma unroll
        for (int e = 0; e < 4; e++) kpk[rr][e] = 0u;
#pragma unroll
      for (int rr = 0; rr < 4; rr++) {
        const int row = 4 * c_rg + rr;
        float o[8];
#pragma unroll
        for (int e = 0; e < 8; e++) o[e] = 0.f;
#pragma unroll
        for (int j = 0; j < 4; j++) {
          const uint4 rw = praw[rr + j];
          const uint32_t w[4] = {rw.x, rw.y, rw.z, rw.w};
#pragma unroll
          for (int e = 0; e < 8; e++) o[e] += bf2f((e & 1) ? (w[e >> 1] >> 16) : (w[e >> 1] & 0xffff)) * cwv[j][e];
        }
        float s = 0.f;
#pragma unroll
        for (int e = 0; e < 8; e++) { o[e] = siluf_(o[e]); s += o[e] * o[e]; }
        s = red16(s);
        float sc = rsqrtf(s + 1e-6f);
        if (c_role == 0) {
          sc *= 0.08838834764831845f;
          *(uint4*)(qn + row * 136 + c_cgp * 8) =
              make_uint4(pack2(o[0] * sc, o[1] * sc), pack2(o[2] * sc, o[3] * sc), pack2(o[4] * sc, o[5] * sc),
                         pack2(o[6] * sc, o[7] * sc));
        } else {
          uint32_t pk[4];
#pragma unroll
          for (int e = 0; e < 4; e++) pk[e] = pack2(o[2 * e] * sc, o[2 * e + 1] * sc);
          *(uint4*)(kn + row * 136 + c_cgp * 8) = make_uint4(pk[0], pk[1], pk[2], pk[3]);
#pragma unroll
          for (int e = 0; e < 4; e++) kpk[rr][e] = pk[e];
        }
      }
      if (c_role == 1) {
#pragma unroll
        for (int e = 0; e < 8; e++) {
          const int sh = (e & 1) * 16;
          const uint32_t r0 = (kpk[0][e >> 1] >> sh) & 0xffffu, r1 = (kpk[1][e >> 1] >> sh) & 0xffffu,
                         r2 = (kpk[2][e >> 1] >> sh) & 0xffffu, r3 = (kpk[3][e >> 1] >> sh) & 0xffffu;
          *(uint2*)(knT + (c_cgp * 8 + e) * 72 + 4 * c_rg) = make_uint2(r0 | (r1 << 16), r2 | (r3 << 16));
        }
      }
      if (tid < 64) {
        const int vb = 256 + (tid & 3) * 8;
        bf16_t vpk[4][8];
#pragma unroll
        for (int rr = 0; rr < 4; rr++) {
          float o[8];
#pragma unroll
          for (int e = 0; e < 8; e++) o[e] = 0.f;
#pragma unroll
          for (int j = 0; j < 4; j++) {
            const uint4 rw = vraw[rr + j];
            const uint32_t w[4] = {rw.x, rw.y, rw.z, rw.w};
#pragma unroll
            for (int e = 0; e < 8; e++)
              o[e] += bf2f((e & 1) ? (w[e >> 1] >> 16) : (w[e >> 1] & 0xffff)) * cw_s[j * 288 + vb + e];
          }
#pragma unroll
          for (int e = 0; e < 8; e++) vpk[rr][e] = f2bf(siluf_(o[e]));
        }
#pragma unroll
        for (int e = 0; e < 8; e++)
          *(uint2*)(vT + ((tid & 3) * 8 + e) * 72 + 4 * v_rg) =
              make_uint2((uint32_t)vpk[0][e] | ((uint32_t)vpk[1][e] << 16), (uint32_t)vpk[2][e] | ((uint32_t)vpk[3][e] << 16));
      }
      prefetch_raw(n + 1);
    }
    {
      int c = tid >> 3, sb = (tid & 7) * 8;
      uint4 raw = Tpre;
      uint32_t w[4] = {raw.x, raw.y, raw.z, raw.w};
      uint32_t ob[4], og[4];
#pragma unroll
      for (int e = 0; e < 4; e++) {
        float t0v = bf2f(w[e] & 0xffff), t1v = bf2f(w[e] >> 16);
        int s0i = sb + 2 * e, s1i = s0i + 1;
        float b0 = be_s[s0i], b1 = be_s[s1i];
        ob[e] = pack2(t0v * b0, t1v * b1);
        og[e] = pack2(t0v * b0 * __expf(gc_s[s0i]), t1v * b1 * __expf(gc_s[s1i]));
      }
      *(uint4*)(Tb + c * 72 + sb) = make_uint4(ob[0], ob[1], ob[2], ob[3]);
      *(uint4*)(Tbg + c * 72 + sb) = make_uint4(og[0], og[1], og[2], og[3]);
      prefetch_small(n + 1);
    }
    __syncthreads();
    tid = tid0; asm volatile("" : "+v"(tid)); lane = tid & 63; wv = tid >> 6;
    {
      const int ta = wv == 0 ? 0 : wv == 1 ? 4 : wv == 2 ? 1 : wv == 3 ? 5 : wv == 5 ? 3 : -1;
      const int tb2 = wv == 2 ? 2 : wv == 3 ? 6 : wv == 5 ? 7 : -1;
#pragma unroll 1
      for (int q = 0; q < 2; q++) {
        const int t8 = q == 0 ? ta : tb2;
        if (t8 >= 0) {
          const int ti = t8 >> 2, tj = t8 & 3;
          f32x16 acc;
#pragma unroll
          for (int r = 0; r < 16; r++) acc[r] = 0.f;
          acc = mm32(Tbg + ti * 32 * 72, 72, knT + tj * 32 * 72, 72, 64, acc, lane);
#pragma unroll
          for (int r = 0; r < 16; r++) wk[(ti * 32 + rowof(r, lane)) * 136 + tj * 32 + (lane & 31)] = f2bf(acc[r]);
        }
      }
    }
    if (wv == 5) {
#pragma unroll
      for (int r = 0; r < 16; r++) attn[rowof(r, lane) * 72 + 32 + (lane & 31)] = 0;
    } else if (wv >= 4) {
      const int ci = (wv - 4) >> 1, si = (wv - 4) & 1;
      f32x16 acc;
#pragma unroll
      for (int r = 0; r < 16; r++) acc[r] = 0.f;
      acc = mm32(qn + ci * 32 * 136, 136, kn + si * 32 * 136, 136, 128, acc, lane);
#pragma unroll
      for (int r = 0; r < 16; r++) {
        int c = ci * 32 + rowof(r, lane), s = si * 32 + (lane & 31);
        float v = (c >= s) ? acc[r] * __expf(gc_s[c] - gc_s[s]) : 0.f;
        attn[c * 72 + s] = f2bf(v);
      }
    } else if (wv < 2) {
#pragma unroll
      for (int r = 0; r < 16; r++) R[r] = 0.f;
      R = mm32(Tb + wv * 32 * 72, 72, vT, 72, 64, R, lane);
    }
    __syncthreads();
    tid = tid0; asm volatile("" : "+v"(tid)); lane = tid & 63; wv = tid >> 6;
    if (wv < 2) {
      f32x16 acc;
#pragma unroll
      for (int r = 0; r < 16; r++) acc[r] = 0.f;
      acc = mm32(wk + wv * 32 * 136, 136, ST, 136, 128, acc, lane);
      const int dv = lane & 31;
#pragma unroll
      for (int g = 0; g < 4; g++) {
        int c0 = wv * 32 + 8 * g + 4 * (lane >> 5);
        float v0 = R[4 * g] - acc[4 * g], v1 = R[4 * g + 1] - acc[4 * g + 1], v2 = R[4 * g + 2] - acc[4 * g + 2],
              v3 = R[4 * g + 3] - acc[4 * g + 3];
        *(uint2*)(vnT + dv * 72 + c0) = make_uint2(pack2(v0, v1), pack2(v2, v3));
        *(uint2*)(ktT + dv * 72 + c0) =
            make_uint2(pack2(v0 * __expf(gl - gc_s[c0]), v1 * __expf(gl - gc_s[c0 + 1])),
                       pack2(v2 * __expf(gl - gc_s[c0 + 2]), v3 * __expf(gl - gc_s[c0 + 3])));
      }
    } else if (wv < 4) {
      const int ti = wv - 2;
#pragma unroll
      for (int r = 0; r < 16; r++) R[r] = 0.f;
      R = mm32(qn + ti * 32 * 136, 136, ST, 136, 128, R, lane);
#pragma unroll
      for (int r = 0; r < 16; r++) R[r] *= __expf(gc_s[ti * 32 + rowof(r, lane)]);
    }
    __syncthreads();
    tid = tid0; asm volatile("" : "+v"(tid)); lane = tid & 63; wv = tid >> 6;
    if (wv >= 2 && wv < 4) {
      const int ti = wv - 2;
      R = mm32(attn + ti * 32 * 72, 72, vnT, 72, 64, R, lane);
      const int dv = lane & 31;
#pragma unroll
      for (int r = 0; r < 16; r++) o_s[(ti * 32 + rowof(r, lane)) * 36 + dv] = f2bf(R[r]);
    } else if (wv >= 4) {
      const int di = wv - 4;
      const float eg = __expf(gl);
#pragma unroll
      for (int r = 0; r < 16; r++) R[r] *= eg;
      R = mm32(knT + di * 32 * 72, 72, ktT, 72, 64, R, lane);
      const int dv = lane & 31;
#pragma unroll
      for (int g = 0; g < 4; g++) {
        int d0 = di * 32 + 8 * g + 4 * (lane >> 5);
        *(uint2*)(ST + dv * 136 + d0) =
            make_uint2(pack2(R[4 * g], R[4 * g + 1]), pack2(R[4 * g + 2], R[4 * g + 3]));
      }
    }
    __syncthreads();
  }
  flush_o(NCHUNK - 1);
  __syncthreads();
}

__device__ __forceinline__ void phase_final(const P& p) {
  const float* h3 = (const float*)(p.ws + W_H3);
  const float* ss = (const float*)(p.ws + W_SS) + 3 * MTOT;
  const int tid_ = otid();
  const int lane = tid_ & 63, wv = tid_ >> 6;
  for (int r = blockIdx.x * 8 + wv; r < NB * SEQ; r += gridDim.x * 8) {
    int b = r / SEQ, t = r - b * SEQ;
    int m = b * TT + NMETA + t;
    float rs = rsqrtf(ss[m] * (1.f / DM) + EPS);
    float4 v4[4], g4[4];
#pragma unroll
    for (int q = 0; q < 4; q++) {
      int c = q * 256 + lane * 4;
      v4[q] = *(const float4*)(h3 + (size_t)m * DM + c);
      g4[q] = *(const float4*)(p.final_norm + c);
    }
#pragma unroll
    for (int q = 0; q < 4; q++) {
      int c = q * 256 + lane * 4;
      float4 v = v4[q], g = g4[q];
      *(float4*)(p.out + (size_t)r * DM + c) = make_float4(v.x * rs * g.x, v.y * rs * g.y, v.z * rs * g.z, v.w * rs * g.w);
    }
  }
}


DEV void grid_barrier(unsigned* bar, unsigned& epoch) {
  __syncthreads();
  if (threadIdx.x == 0) {
    epoch++;
    const unsigned g = blockIdx.x & 7u;
    const unsigned gsize = (gridDim.x >> 3) + ((gridDim.x & 7u) > g ? 1u : 0u);
    const unsigned ngroups = gridDim.x < 8u ? gridDim.x : 8u;
    __threadfence();
    asm volatile("s_waitcnt vmcnt(0) lgkmcnt(0)" ::: "memory");
    unsigned v = __hip_atomic_fetch_add(&bar[g * 64], 1u, __ATOMIC_RELAXED, __HIP_MEMORY_SCOPE_AGENT) + 1u;
    if (v == gsize * epoch) __hip_atomic_fetch_add(&bar[512], 1u, __ATOMIC_RELAXED, __HIP_MEMORY_SCOPE_AGENT);
    while (__hip_atomic_load(&bar[512], __ATOMIC_RELAXED, __HIP_MEMORY_SCOPE_AGENT) < ngroups * epoch)
      __builtin_amdgcn_s_sleep(1);
    __threadfence();
    asm volatile("s_waitcnt vmcnt(0) lgkmcnt(0)" ::: "memory");
  }
  __syncthreads();
}

__global__ void __launch_bounds__(512) mega(P p) {
  extern __shared__ __attribute__((aligned(16))) char smem[];
  cg::grid_group grid = cg::this_grid();
  unsigned* bar = (unsigned*)(p.ws + W_BAR);
  unsigned epoch = 0;
#ifdef USE_CG_SYNC
#define GSYNC() grid.sync()
#else
#define GSYNC() grid_barrier(bar, epoch)
#endif
  const bf16_t* arena = (const bf16_t*)p.out;
  const bf16_t* hb = (const bf16_t*)(p.ws + W_HB);
  const bf16_t* act = (const bf16_t*)(p.ws + W_ACT);
  const bf16_t* z = (const bf16_t*)(p.ws + W_Z);
  const bf16_t* sg = (const bf16_t*)(p.ws + W_SG);

  phase0(p, smem);
  grid.sync();
  gemm_big<EPI_SWIGLU>(p, smem, hb, DM, MTOT, arena + A_WGU1, DM, 22, 0);
  GSYNC();
  gemm_phase<EPI_DOWN1>(p, smem, act, DFF, MTOT, arena + A_WD1, DFF, 8, 0);
  GSYNC();
  const bf16_t* oab = (const bf16_t*)(p.ws + W_OA);
  gemm_big<EPI_WIN>(p, smem, hb, DM, MH, arena + A_WIN, DM, 38, 0);
  GSYNC();
  for (int half = 0; half < 2; half++) {
    phase4(p, smem);
    GSYNC();
    for (int job = blockIdx.x; job < 192; job += gridDim.x) {
      {
      if (job < 128) rwkv_block(p, smem, job >> 2, job & 3);
      else delta_block(p, smem, (job - 128) >> 2, (job - 128) & 3);
      }
      __syncthreads();
    }
    GSYNC();
    gemm_phase<EPI_MERGE>(p, smem, sg, 192, MH, arena + A_GUP, 192, 8, half);
    GSYNC();
    gemm_phase<EPI_WOUT>(p, smem, oab, DM, MH, arena + A_WOUT, DM, 8, half);
    if (half == 0) gemm_big<EPI_WIN>(p, smem, hb + (size_t)MH * DM, DM, MH, arena + A_WIN, DM, 38, 1);
    GSYNC();
  }
  gemm_big<EPI_SWIGLU>(p, smem, hb, DM, MTOT, arena + A_WGU2, DM, 22, 1);
  GSYNC();
  gemm_phase<EPI_DOWN2>(p, smem, act, DFF, MTOT, arena + A_WD2, DFF, 8, 0);
  GSYNC();
  phase_final(p);
}

extern "C" void kernel_launch(void* const* d_in, const int* in_sizes, int n_in, void* d_out, int out_size, void* d_ws,
                              size_t ws_size, hipStream_t stream) {
  static int grid_blocks = 0;
  if (!grid_blocks) {
    int dev = 0, cus = 0, per_cu = 0;
    hipGetDevice(&dev);
    hipDeviceGetAttribute(&cus, hipDeviceAttributeMultiprocessorCount, dev);
    hipFuncSetAttribute((const void*)mega, hipFuncAttributeMaxDynamicSharedMemorySize, LDS_BYTES);
    hipOccupancyMaxActiveBlocksPerMultiprocessor(&per_cu, mega, 512, LDS_BYTES);
    if (per_cu < 1) per_cu = 1;
    if (per_cu > 1) per_cu = 1;
    grid_blocks = cus * per_cu;
  }
  P p{};
  const float* const* in = (const float* const*)d_in;
  p.x = in[0]; p.meta = in[1]; p.ffn1_norm = in[2]; p.ffn1_wgu = in[3]; p.ffn1_wd = in[4]; p.mix_norm = in[5];
  p.w_in = in[6]; p.conv_w = in[7]; p.log_rate = in[8]; p.dt_bias = in[9]; p.out_norm = in[10]; p.mu = in[11];
  p.w0 = in[12]; p.w_up = in[13]; p.a0 = in[14]; p.a_up = in[15]; p.g_up = in[16]; p.k_k = in[17]; p.k_a = in[18];
  p.r_k = in[19]; p.ln_g = in[20]; p.ln_b = in[21]; p.w_out = in[22]; p.ffn2_norm = in[23]; p.ffn2_wgu = in[24];
  p.ffn2_wd = in[25]; p.final_norm = in[26];
  p.out = (float*)d_out;
  p.ws = (char*)d_ws;
  (void)hipMemsetAsync((char*)d_ws + W_BAR, 0, 4096, stream);
  void* args[] = {&p};
  hipError_t e = hipLaunchCooperativeKernel((void*)mega, dim3(grid_blocks), dim3(512), args, LDS_BYTES, stream);
  if (e != hipSuccess) fprintf(stderr, "cooperative launch failed: %s (grid %d)\n", hipGetErrorString(e), grid_blocks);
}
```

```cpp
#include <hip/hip_runtime.h>
#include <hip/hip_cooperative_groups.h>
#include <stdint.h>
#include <stdio.h>
namespace cg = cooperative_groups;

typedef unsigned short bf16_t;
using bf16x8 = __attribute__((ext_vector_type(8))) short;
using f32x16 = __attribute__((ext_vector_type(16))) float;

#define DEV __device__ __forceinline__

constexpr int NB = 4, SEQ = 4096, NMETA = 16, TT = 4112, MTOT = NB * TT;
constexpr int DM = 1024, DFF = 2816, NIN = 9520, NINP = 9728;
constexpr int MH = 2 * TT;
constexpr int NCHUNK = 65;
constexpr int ZRW = 4112;
constexpr float EPS = 1e-6f;

constexpr size_t A_WGU1 = 0;
constexpr size_t A_WD1 = A_WGU1 + (size_t)2 * DFF * DM;
constexpr size_t A_WIN = A_WD1 + (size_t)DM * DFF;
constexpr size_t A_WOUT = A_WIN + (size_t)NINP * DM;
constexpr size_t A_WGU2 = A_WOUT + (size_t)DM * DM;
constexpr size_t A_WD2 = A_WGU2 + (size_t)2 * DFF * DM;
constexpr size_t A_GUP = A_WD2 + (size_t)DM * DFF;
constexpr size_t A_END = A_GUP + (size_t)DM * 192;
static_assert(A_END * 2 <= (size_t)NB * SEQ * DM * 4, "arena overflow");

constexpr size_t W_HB = 0;
constexpr size_t W_SS = W_HB + (size_t)MTOT * DM * 2;
constexpr size_t W_Z = W_SS + (size_t)4 * MTOT * 4;
constexpr size_t W_ACT = W_Z;
constexpr size_t W_H3 = W_Z + (size_t)MTOT * DFF * 2;
constexpr size_t W_BA = W_Z + (size_t)MH * NIN * 2;
constexpr size_t W_GB = W_BA + (size_t)MH * 16 * 4;
constexpr size_t W_BB = W_GB + (size_t)16 * NCHUNK * 64 * 4;
constexpr size_t W_TT = W_BB + (size_t)16 * NCHUNK * 64 * 4;
constexpr size_t W_OA = W_TT + (size_t)16 * NCHUNK * 4096 * 2;
constexpr size_t W_OST = W_OA + (size_t)MH * DM * 2;
constexpr size_t W_YB = W_OST + (size_t)MH * 32 * 4;
constexpr size_t W_YST = W_YB + (size_t)MH * DM * 2;
constexpr size_t W_BON = W_YST + (size_t)MH * 128 * 4;
constexpr size_t W_SG = W_BON + (size_t)MH * DM * 2;
constexpr size_t W_END = W_SG + (size_t)MH * 192 * 2;
constexpr size_t W_BAR = (W_END + 255) / 256 * 256;
constexpr size_t W_XWA = W_BAR + 4096;
static_assert(W_XWA + (size_t)MH * 128 * 2 <= (size_t)256 * 1024 * 1024, "ws overflow");
static_assert(W_H3 + (size_t)MTOT * DM * 4 <= (size_t)256 * 1024 * 1024, "ws overflow h3");

constexpr int LDS_BYTES = 147456;

struct P {
  const float *x, *meta, *ffn1_norm, *ffn1_wgu, *ffn1_wd, *mix_norm, *w_in, *conv_w, *log_rate, *dt_bias, *out_norm,
      *mu, *w0, *w_up, *a0, *a_up, *g_up, *k_k, *k_a, *r_k, *ln_g, *ln_b, *w_out, *ffn2_norm, *ffn2_wgu, *ffn2_wd,
      *final_norm;
  float* out;
  char* ws;
};

DEV bf16_t f2bf(float f) {
  uint32_t u = __float_as_uint(f);
  u += 0x7fffu + ((u >> 16) & 1u);
  return (bf16_t)(u >> 16);
}
DEV float bf2f(bf16_t b) { return __uint_as_float(((uint32_t)b) << 16); }
DEV uint32_t pack2(float a, float b) { return (uint32_t)f2bf(a) | ((uint32_t)f2bf(b) << 16); }
DEV float rcpf_(float x) { return __builtin_amdgcn_rcpf(x); }
DEV float sigmoidf_(float x) { return rcpf_(1.f + __expf(-x)); }
DEV float siluf_(float x) { return x * rcpf_(1.f + __expf(-x)); }
DEV float softplusf_(float x) { return x > 20.f ? x : log1pf(__expf(x)); }

template <int CTRL>
DEV float dpp_f(float v) {
  return __int_as_float(__builtin_amdgcn_update_dpp(0, __float_as_int(v), CTRL, 0xf, 0xf, true));
}
DEV float red16(float v) {
  v += dpp_f<0xB1>(v);
  v += dpp_f<0x4E>(v);
  v += dpp_f<0x141>(v);
  v += dpp_f<0x140>(v);
  return v;
}
DEV float red32(float v) { v = red16(v); v += __shfl_xor(v, 16); return v; }
DEV float red64(float v) { v = red32(v); v += __shfl_xor(v, 32); return v; }

DEV const float* h0row(const P& p, int m) {
  int b = m / TT, t = m - b * TT;
  return t < NMETA ? p.meta + (size_t)t * DM : p.x + ((size_t)b * SEQ + (t - NMETA)) * DM;
}

DEV f32x16 mm32(const bf16_t* A, int lda, const bf16_t* Bt, int ldb, int K, f32x16 acc, int lane) {
  const bf16_t* ap = A + (lane & 31) * lda + (lane >> 5) * 8;
  const bf16_t* bp = Bt + (lane & 31) * ldb + (lane >> 5) * 8;
  for (int k = 0; k < K; k += 16) {
    bf16x8 a = *(const bf16x8*)(ap + k);
    bf16x8 b = *(const bf16x8*)(bp + k);
    acc = __builtin_amdgcn_mfma_f32_32x32x16_bf16(a, b, acc, 0, 0, 0);
  }
  return acc;
}
DEV int otid() { int t = threadIdx.x; asm volatile("" : "+v"(t)); return t; }
#define WAVE_FENCE() asm volatile("s_waitcnt lgkmcnt(0)" ::: "memory")
DEV int rowof(int r, int lane) { return 8 * (r >> 2) + 4 * (lane >> 5) + (r & 3); }

__device__ __forceinline__ void convert_matrix(const float* __restrict__ src, int Ksrc, int Nsrc, bf16_t* __restrict__ dst, int Rows,
                               int validRows, int Kdst, const float* __restrict__ scale, int mode, char* smem) {
  float* tile = (float*)smem;
  constexpr int NU = 4;
  const int tid = otid();
  const int kt_n = Kdst / 64;
  const int units = (Rows / 64) * kt_n;
  for (int u0 = blockIdx.x; u0 < units; u0 += NU * gridDim.x) {
    float v[NU][8];
#pragma unroll
    for (int w = 0; w < NU; w++) {
      const int u = u0 + w * gridDim.x;
      const int R0 = (u / kt_n) * 64, k0 = (u % kt_n) * 64;
#pragma unroll
      for (int q = 0; q < 8; q++) {
        const int e = tid + 512 * q;
        const int kk = e >> 6, rr = e & 63;
        const int R = R0 + rr, k = k0 + kk;
        float x = 0.f;
        if (u < units && R < validRows && k < Ksrc) {
          int col = R;
          if (mode == 1) {
            int j = R >> 7, r = R & 127;
            int wn = r >> 6, i = (r >> 5) & 1, pp = r & 31;
            col = (i ? DFF : 0) + j * 64 + wn * 32 + pp;
          }
          x = src[(size_t)k * Nsrc + col];
          if (scale) x *= scale[k];
        }
        v[w][q] = x;
      }
    }
#pragma unroll
    for (int w = 0; w < NU; w++)
#pragma unroll
      for (int q = 0; q < 8; q++) {
        const int e = tid + 512 * q;
        tile[w * 4160 + (e & 63) * 65 + (e >> 6)] = v[w][q];
      }
    __syncthreads();
#pragma unroll
    for (int w = 0; w < NU; w++) {
      const int u = u0 + w * gridDim.x;
      if (u < units) {
        const int R0 = (u / kt_n) * 64, k0 = (u % kt_n) * 64;
        const int rr = tid >> 3, kk0 = (tid & 7) * 8;
        const float* tp = tile + w * 4160 + rr * 65 + kk0;
        *(uint4*)(dst + (size_t)(R0 + rr) * Kdst + k0 + kk0) =
            make_uint4(pack2(tp[0], tp[1]), pack2(tp[2], tp[3]), pack2(tp[4], tp[5]), pack2(tp[6], tp[7]));
      }
    }
    __syncthreads();
  }
}

__device__ __forceinline__ void phase0(const P& p, char* smem) {
  bf16_t* arena = (bf16_t*)p.out;
  convert_matrix(p.ffn1_wgu, DM, 2 * DFF, arena + A_WGU1, 2 * DFF, 2 * DFF, DM, p.ffn1_norm, 1, smem);
  convert_matrix(p.ffn1_wd, DFF, DM, arena + A_WD1, DM, DM, DFF, nullptr, 0, smem);
  convert_matrix(p.w_in, DM, NIN, arena + A_WIN, NINP, NIN, DM, p.mix_norm, 0, smem);
  convert_matrix(p.w_out, DM, DM, arena + A_WOUT, DM, DM, DM, nullptr, 0, smem);
  convert_matrix(p.ffn2_wgu, DM, 2 * DFF, arena + A_WGU2, 2 * DFF, 2 * DFF, DM, p.ffn2_norm, 1, smem);
  convert_matrix(p.ffn2_wd, DFF, DM, arena + A_WD2, DM, DM, DFF, nullptr, 0, smem);
  convert_matrix(p.g_up, 160, DM, arena + A_GUP, DM, DM, 192, nullptr, 0, smem);
  bf16_t* hb = (bf16_t*)(p.ws + W_HB);
  float* ss = (float*)(p.ws + W_SS);
  const int tid_ = otid();
  const int lane = tid_ & 63, wv = tid_ >> 6;
  for (int m = blockIdx.x * 8 + wv; m < MTOT; m += gridDim.x * 8) {
    const float* src = h0row(p, m);
    float s = 0.f;
    float4 v4[4];
#pragma unroll
    for (int q = 0; q < 4; q++) v4[q] = *(const float4*)(src + q * 256 + lane * 4);
#pragma unroll
    for (int q = 0; q < 4; q++) {
      int c = q * 256 + lane * 4;
      float4 v = v4[q];
      uint32_t lo = pack2(v.x, v.y), hi = pack2(v.z, v.w);
      float a0 = bf2f(lo & 0xffff), a1 = bf2f(lo >> 16), a2 = bf2f(hi & 0xffff), a3 = bf2f(hi >> 16);
      s += a0 * a0 + a1 * a1 + a2 * a2 + a3 * a3;
      *(uint2*)(hb + (size_t)m * DM + c) = make_uint2(lo, hi);
    }
    s = red64(s);
    if (lane == 0) { ss[m] = s; ss[MTOT + m] = 0.f; ss[2 * MTOT + m] = 0.f; ss[3 * MTOT + m] = 0.f; }
  }
}

using u32x4 = __attribute__((ext_vector_type(4))) unsigned;
DEV void gld16(u32x4& r, const void* ptr) { asm volatile("global_load_dwordx4 %0, %1, off" : "=v"(r) : "v"(ptr) : "memory"); }
#define GLD_WAIT() asm volatile("s_waitcnt vmcnt(0)" ::: "memory")
DEV void gld16s(u32x4& r, const void* base, uint32_t off) {
  asm volatile("s_nop 4\n\tglobal_load_dwordx4 %0, %1, %2" : "=v"(r) : "v"(off), "s"(base) : "memory");
}
enum { EPI_SWIGLU = 0, EPI_DOWN1, EPI_WIN, EPI_MERGE, EPI_WOUT, EPI_DOWN2 };

struct EA {
  const P* p;
  int half;
};


template <int EPI, int SPLIT = 0>
__device__ __forceinline__ void gemm_phase(const P& p, char* smem_all, const bf16_t* __restrict__ X, int ldx, int Mrows,
                           const bf16_t* __restrict__ W, int K, int Ntiles, int half, bool dry_in = false) {
  constexpr int MT = SPLIT ? 128 : 256;
  constexpr int NTHR = SPLIT ? 256 : 512;
  constexpr int RSTEP = NTHR / 8;
  constexpr int NWL = 128 / RSTEP, NXL = MT / RSTEP;
  constexpr int STAGE = (128 + MT) * 72 * 2;
  const int tid = otid(), lane = tid & 63, wv = tid >> 6;
  const int grp = SPLIT ? (wv >> 2) : 0;
  const int wl = SPLIT ? (wv & 3) : wv;
  const int wn = wl & 1, wm = wl >> 1;
  char* smem = smem_all + grp * (2 * STAGE);
  const int Mtiles = (Mrows + MT - 1) / MT;
  const int total = Mtiles * Ntiles;
  const int KT = K / 64;
  const int gt = SPLIT ? (tid & 255) : tid;
  const int lrow = gt >> 3, lcol = (gt & 7) * 8;
  float* ss = (float*)(p.ws + W_SS);
  bf16_t* hb = (bf16_t*)(p.ws + W_HB);
  const int tstep = SPLIT ? 2 : 1;
  const int G8 = (gridDim.x & 7) == 0 ? (int)(gridDim.x >> 3) : 0;
  const int pb = (G8 && !SPLIT) ? (int)((blockIdx.x & 7) * G8 + (blockIdx.x >> 3)) : (int)blockIdx.x;
  const int mfull = (Mtiles >> 2) << 2, nfull = mfull * Ntiles, mrem = Mtiles - mfull;
  for (int tbase = pb * tstep; tbase < total; tbase += gridDim.x * tstep) {
    int tile = tbase + grp;
    const bool dry = dry_in || (tile >= total);
    tile = tile < total ? tile : total - 1;
    int mt, nt;
    if (SPLIT) { mt = tile / Ntiles; nt = tile - mt * Ntiles; }
    else if (tile < nfull) {
      const int rg = tile / (4 * Ntiles), rem = tile - rg * 4 * Ntiles;
      nt = rem >> 2;
      mt = rg * 4 + (rem & 3);
    } else {
      const int rem = tile - nfull;
      nt = rem / mrem;
      mt = mfull + (rem - nt * mrem);
    }
    const int m0 = mt * MT, n0 = nt * 128;
    u32x4 w0r[NWL], x0r[NXL], w1r[NWL], x1r[NXL];
    f32x16 acc[2][2];
#pragma unroll
    for (int i = 0; i < 2; i++)
#pragma unroll
      for (int j = 0; j < 2; j++)
#pragma unroll
        for (int r = 0; r < 16; r++) acc[i][j][r] = 0.f;

    auto gload = [&](u32x4 (&wr)[NWL], u32x4 (&xr)[NXL], int kt) {
#pragma unroll
      for (int q = 0; q < NWL; q++) {
        int row = lrow + RSTEP * q;
        gld16(wr[q], W + (size_t)(n0 + row) * K + kt * 64 + lcol);
      }
#pragma unroll
      for (int q = 0; q < NXL; q++) {
        int row = m0 + lrow + RSTEP * q;
        row = row < Mrows ? row : Mrows - 1;
        gld16(xr[q], X + (size_t)row * ldx + kt * 64 + lcol);
      }
    };
    auto sstore = [&](u32x4 (&wr)[NWL], u32x4 (&xr)[NXL], int st) {
      bf16_t* Ws = (bf16_t*)(smem + st * STAGE);
      bf16_t* Xs = Ws + 128 * 72;
#pragma unroll
      for (int q = 0; q < NWL; q++) *(u32x4*)(Ws + (lrow + RSTEP * q) * 72 + lcol) = wr[q];
#pragma unroll
      for (int q = 0; q < NXL; q++) *(u32x4*)(Xs + (lrow + RSTEP * q) * 72 + lcol) = xr[q];
    };
    const bool wact = __builtin_amdgcn_readfirstlane(m0 + wm * 64) < Mrows;
    auto compute = [&](int st) {
      if (!wact) return;
      const bf16_t* Ws = (const bf16_t*)(smem + st * STAGE);
      const bf16_t* Xs = Ws + 128 * 72;
      const bf16_t* ap = Ws + (wn * 64 + (lane & 31)) * 72 + (lane >> 5) * 8;
      const bf16_t* bp = Xs + (wm * 64 + (lane & 31)) * 72 + (lane >> 5) * 8;
#pragma unroll
      for (int kk = 0; kk < 4; kk++) {
        bf16x8 a0 = *(const bf16x8*)(ap + kk * 16);
        bf16x8 a1 = *(const bf16x8*)(ap + 32 * 72 + kk * 16);
        bf16x8 b0 = *(const bf16x8*)(bp + kk * 16);
        bf16x8 b1 = *(const bf16x8*)(bp + 32 * 72 + kk * 16);
        acc[0][0] = __builtin_amdgcn_mfma_f32_32x32x16_bf16(a0, b0, acc[0][0], 0, 0, 0);
        acc[0][1] = __builtin_amdgcn_mfma_f32_32x32x16_bf16(a0, b1, acc[0][1], 0, 0, 0);
        acc[1][0] = __builtin_amdgcn_mfma_f32_32x32x16_bf16(a1, b0, acc[1][0], 0, 0, 0);
        acc[1][1] = __builtin_amdgcn_mfma_f32_32x32x16_bf16(a1, b1, acc[1][1], 0, 0, 0);
      }
    };
    auto kstep = [&](u32x4 (&wr)[NWL], u32x4 (&xr)[NXL], int kt) {
      compute(kt & 1);
      if (kt + 1 < KT) {
        if (kt + 2 < KT) asm volatile("s_waitcnt vmcnt(%0)" ::"n"(NWL + NXL) : "memory");
        else GLD_WAIT();
        sstore(wr, xr, (kt + 1) & 1);
        if (kt + 3 < KT) gload(wr, xr, kt + 3);
      }
      __syncthreads();
    };
    gload(w0r, x0r, 0);
    GLD_WAIT();
    sstore(w0r, x0r, 0);
    if (KT > 1) gload(w1r, x1r, 1);
    if (KT > 2) gload(w0r, x0r, 2);
    __syncthreads();
    for (int kt = 0; kt < KT; kt += 2) {
      kstep(w1r, x1r, kt);
      if (kt + 1 < KT) kstep(w0r, x0r, kt + 1);
    }
    const int hh = lane >> 5;
    float* cst_s = (float*)(smem_all + 2 * STAGE);
    if (EPI == EPI_MERGE) {
      if (tid < 384) {
        const int a = tid >> 7, cl = tid & 127, c = n0 + cl;
        cst_s[tid] = a == 0 ? p.out_norm[c & 127] : (a == 1 ? p.ln_g[c] : p.ln_b[c]);
      }
      __syncthreads();
    }
#pragma unroll
    for (int j = 0; j < 2; j++) {
      if (__builtin_amdgcn_readfirstlane(m0 + wm * 64 + j * 32) >= Mrows) continue;
      const int m = m0 + wm * 64 + j * 32 + (lane & 31);
      const bool mv = (m < Mrows) && !dry;
      const int mc = mv ? m : Mrows - 1;
      if (EPI == EPI_SWIGLU) {
        const float rs = rsqrtf(ss[(half ? 2 : 0) * MTOT + mc] * (1.f / DM) + EPS);
        bf16_t* act = (bf16_t*)(p.ws + W_ACT);
#pragma unroll
        for (int g = 0; g < 4; g++) {
          float o[4];
#pragma unroll
          for (int e = 0; e < 4; e++) {
            float gt = acc[0][j][4 * g + e] * rs, up = acc[1][j][4 * g + e] * rs;
            o[e] = siluf_(gt) * up;
          }
          int col = nt * 64 + wn * 32 + 8 * g + 4 * hh;
          if (mv) *(uint2*)(act + (size_t)m * DFF + col) = make_uint2(pack2(o[0], o[1]), pack2(o[2], o[3]));
        }
      } else if (EPI == EPI_DOWN1 || EPI == EPI_WOUT || EPI == EPI_DOWN2) {
        const int mg = (EPI == EPI_WOUT) ? half * MH + mc : mc;
        float ssq = 0.f;
        const float* h0 = (EPI == EPI_DOWN1) ? h0row(p, mg) : nullptr;
        float* h3 = (float*)(p.ws + W_H3);
        float4 rf[2][4];
        uint2 rb[2][4];
#pragma unroll
        for (int i = 0; i < 2; i++)
#pragma unroll
          for (int g = 0; g < 4; g++) {
            const int n = n0 + wn * 64 + i * 32 + 8 * g + 4 * hh;
            if (EPI == EPI_DOWN1) rf[i][g] = *(const float4*)(h0 + n);
            else rb[i][g] = *(const uint2*)(hb + (size_t)mg * DM + n);
          }
#pragma unroll
        for (int i = 0; i < 2; i++)
#pragma unroll
          for (int g = 0; g < 4; g++) {
            const int n = n0 + wn * 64 + i * 32 + 8 * g + 4 * hh;
            float o[4];
            if (EPI == EPI_DOWN1) {
              const float4 r = rf[i][g];
              o[0] = r.x + 0.5f * acc[i][j][4 * g + 0];
              o[1] = r.y + 0.5f * acc[i][j][4 * g + 1];
              o[2] = r.z + 0.5f * acc[i][j][4 * g + 2];
              o[3] = r.w + 0.5f * acc[i][j][4 * g + 3];
            } else {
              const uint2 r = rb[i][g];
              const float sc = (EPI == EPI_WOUT) ? 1.f : 0.5f;
              o[0] = bf2f(r.x & 0xffff) + sc * acc[i][j][4 * g + 0];
              o[1] = bf2f(r.x >> 16) + sc * acc[i][j][4 * g + 1];
              o[2] = bf2f(r.y & 0xffff) + sc * acc[i][j][4 * g + 2];
              o[3] = bf2f(r.y >> 16) + sc * acc[i][j][4 * g + 3];
            }
            if (EPI == EPI_DOWN2) {
              ssq += o[0] * o[0] + o[1] * o[1] + o[2] * o[2] + o[3] * o[3];
              if (mv) *(float4*)(h3 + (size_t)mg * DM + n) = make_float4(o[0], o[1], o[2], o[3]);
            } else {
              uint32_t lo = pack2(o[0], o[1]), hi = pack2(o[2], o[3]);
              float q0 = bf2f(lo & 0xffff), q1 = bf2f(lo >> 16), q2 = bf2f(hi & 0xffff), q3 = bf2f(hi >> 16);
              ssq += q0 * q0 + q1 * q1 + q2 * q2 + q3 * q3;
              if (mv) *(uint2*)(hb + (size_t)mg * DM + n) = make_uint2(lo, hi);
            }
          }
        ssq += __shfl_xor(ssq, 32);
        const int which = (EPI == EPI_DOWN1) ? 1 : (EPI == EPI_WOUT ? 2 : 3);
        if (mv && hh == 0) atomicAdd(&ss[which * MTOT + mg], ssq);
      } else if (EPI == EPI_WIN) {
        const int mg = half * MH + mc;
        const float rs = rsqrtf(ss[1 * MTOT + mg] * (1.f / DM) + EPS);
        bf16_t* z = (bf16_t*)(p.ws + W_Z);
        float* ba = (float*)(p.ws + W_BA);
#pragma unroll
        for (int i = 0; i < 2; i++)
#pragma unroll
          for (int g = 0; g < 4; g++) {
            const int n = n0 + wn * 64 + i * 32 + 8 * g + 4 * hh;
            float o0 = acc[i][j][4 * g + 0] * rs, o1 = acc[i][j][4 * g + 1] * rs, o2 = acc[i][j][4 * g + 2] * rs,
                  o3 = acc[i][j][4 * g + 3] * rs;
            if (mv && n < NIN) {
              *(uint2*)(z + (size_t)m * NIN + n) = make_uint2(pack2(o0, o1), pack2(o2, o3));
              if (n >= 4096 && n < 4112) *(float4*)(ba + (size_t)m * 16 + (n - 4096)) = make_float4(o0, o1, o2, o3);
            }
          }
      } else if (EPI == EPI_MERGE) {
        bf16_t* z = (bf16_t*)(p.ws + W_Z);
        const bf16_t* oa = (const bf16_t*)(p.ws + W_OA);
        const float* ost = (const float*)(p.ws + W_OST);
        const bf16_t* yb = (const bf16_t*)(p.ws + W_YB);
        const float* yst = (const float*)(p.ws + W_YST);
        const bf16_t* bon = (const bf16_t*)(p.ws + W_BON);
        const int cw0 = n0 + wn * 64;
        const float4 os = *(const float4*)(ost + ((size_t)mc * 8 + (cw0 >> 7)) * 4);
        const float* ys = yst + ((size_t)mc * 16 + (cw0 >> 6)) * 8;
        const float4 y0 = *(const float4*)ys, y1 = *(const float4*)(ys + 4);
        const float rstd_a = rsqrtf((os.x + os.y + os.z + os.w) * (1.f / 128.f) + EPS);
        const float sy = y0.x + y0.z + y1.x + y1.z, sy2 = y0.y + y0.w + y1.y + y1.w;
        const float mean = sy * (1.f / 64.f);
        const float var = fmaxf(sy2 * (1.f / 64.f) - mean * mean, 0.f);
        const float rstd_b = rsqrtf(var + 64e-5f);
#pragma unroll
        for (int i = 0; i < 2; i++) {
          uint2 L[4][6];
#pragma unroll
          for (int g = 0; g < 4; g++) {
            const int c = cw0 + i * 32 + 8 * g + 4 * hh;
            L[g][0] = *(const uint2*)(oa + (size_t)mc * DM + c);
            L[g][1] = *(const uint2*)(yb + (size_t)mc * DM + c);
            L[g][2] = *(const uint2*)(bon + (size_t)mc * DM + c);
            L[g][3] = *(const uint2*)(z + (size_t)mc * NIN + 3072 + c);
            L[g][4] = *(const uint2*)(z + (size_t)mc * NIN + 7472 + c);
            L[g][5] = *(const uint2*)(z + (size_t)mc * NIN + 8496 + c);
          }
#pragma unroll
          for (int g = 0; g < 4; g++) {
            const int c = cw0 + i * 32 + 8 * g + 4 * hh;
            const int cl = c - n0;
            const float4 on4 = *(const float4*)(cst_s + cl), lg4 = *(const float4*)(cst_s + 128 + cl),
                         lb4 = *(const float4*)(cst_s + 256 + cl);
            const float onv[4] = {on4.x, on4.y, on4.z, on4.w}, lgv[4] = {lg4.x, lg4.y, lg4.z, lg4.w},
                        lbv[4] = {lb4.x, lb4.y, lb4.z, lb4.w};
            float o[4];
#pragma unroll
            for (int e = 0; e < 4; e++) {
              auto sel = [&](uint2 v) { uint32_t w = (e < 2) ? v.x : v.y; return bf2f((e & 1) ? (w >> 16) : (w & 0xffff)); };
              float oav = sel(L[g][0]) * rstd_a * onv[e] * siluf_(sel(L[g][3]));
              float yn = (sel(L[g][1]) - mean) * rstd_b * lgv[e] + lbv[e] + sel(L[g][2]);
              float obv = yn * acc[i][j][4 * g + e];
              o[e] = sigmoidf_(sel(L[g][4])) * oav + sigmoidf_(sel(L[g][5])) * obv;
            }
            if (mv) *(uint2*)((bf16_t*)oa + (size_t)m * DM + c) = make_uint2(pack2(o[0], o[1]), pack2(o[2], o[3]));
          }
        }
      }
    }
    if (EPI == EPI_MERGE) __syncthreads();
  }
}


template <int EPI>
__device__ __forceinline__ void gemm_big(const P& p, char* smem, const bf16_t* __restrict__ X, int ldx, int Mrows,
                                         const bf16_t* __restrict__ W, int K, int Ntiles, int half) {
  constexpr int STAGE = 512 * 72 * 2;
  const int tid = otid(), lane = tid & 63, wv = tid >> 6;
  const int wn = wv & 1, wm = wv >> 1;
  const int Mtiles = (Mrows + 255) / 256;
  const int total = Mtiles * Ntiles;
  const int KT = K / 64;
  const int lrow = tid >> 3, lcol = (tid & 7) * 8;
  float* ss = (float*)(p.ws + W_SS);
  const int G8 = (gridDim.x & 7) == 0 ? (int)(gridDim.x >> 3) : 0;
  const int pb = G8 ? (int)((blockIdx.x & 7) * G8 + (blockIdx.x >> 3)) : (int)blockIdx.x;
  const int mfull = (Mtiles >> 2) << 2, nfull = mfull * Ntiles, mrem = Mtiles - mfull;
  for (int tile = pb; tile < total; tile += gridDim.x) {
    int mt, nt;
    if (tile < nfull) {
      const int rg = tile / (4 * Ntiles), rem = tile - rg * 4 * Ntiles;
      nt = rem >> 2;
      mt = rg * 4 + (rem & 3);
    } else {
      const int rem = tile - nfull;
      nt = rem / mrem;
      mt = mfull + (rem - nt * mrem);
    }
    const int m0 = mt * 256, n0 = nt * 256;
    u32x4 wr[4], xr[4];
    f32x16 acc[4][2];
#pragma unroll
    for (int i = 0; i < 4; i++)
#pragma unroll
      for (int j = 0; j < 2; j++)
#pragma unroll
        for (int r = 0; r < 16; r++) acc[i][j][r] = 0.f;
    uint32_t woff[4], xoff[4];
#pragma unroll
    for (int q = 0; q < 4; q++) {
      woff[q] = (uint32_t)(((size_t)(n0 + lrow + 64 * q) * K + lcol) * 2);
      int row = m0 + lrow + 64 * q;
      row = row < Mrows ? row : Mrows - 1;
      xoff[q] = (uint32_t)(((size_t)row * ldx + lcol) * 2);
    }
    auto gload = [&](int kt) {
      const bf16_t* wb = W + kt * 64;
      const bf16_t* xb = X + kt * 64;
#pragma unroll
      for (int q = 0; q < 4; q++) gld16s(wr[q], wb, woff[q]);
#pragma unroll
      for (int q = 0; q < 4; q++) gld16s(xr[q], xb, xoff[q]);
    };
    auto sstore = [&](int st) {
      bf16_t* Ws = (bf16_t*)(smem + st * STAGE);
      bf16_t* Xs = Ws + 256 * 72;
#pragma unroll
      for (int q = 0; q < 4; q++) *(u32x4*)(Ws + (lrow + 64 * q) * 72 + lcol) = wr[q];
#pragma unroll
      for (int q = 0; q < 4; q++) *(u32x4*)(Xs + (lrow + 64 * q) * 72 + lcol) = xr[q];
    };
    const bool wact = __builtin_amdgcn_readfirstlane(m0 + wm * 64) < Mrows;
    gload(0);
    GLD_WAIT();
    sstore(0);
    if (KT > 1) gload(1);
    __syncthreads();
    for (int kt = 0; kt < KT; kt++) {
      if (wact) {
        const bf16_t* Ws = (const bf16_t*)(smem + (kt & 1) * STAGE);
        const bf16_t* Xs = Ws + 256 * 72;
        const bf16_t* ap = Ws + (wn * 128 + (lane & 31)) * 72 + (lane >> 5) * 8;
        const bf16_t* bp = Xs + (wm * 64 + (lane & 31)) * 72 + (lane >> 5) * 8;
        bf16x8 b0 = *(const bf16x8*)(bp), b1 = *(const bf16x8*)(bp + 32 * 72);
        bf16x8 a0 = *(const bf16x8*)(ap), a1 = *(const bf16x8*)(ap + 32 * 72), a2 = *(const bf16x8*)(ap + 64 * 72),
               a3 = *(const bf16x8*)(ap + 96 * 72);
#pragma unroll
        for (int kk = 0; kk < 4; kk++) {
          bf16x8 nb0, nb1, na0, na1, na2, na3;
          if (kk < 3) {
            nb0 = *(const bf16x8*)(bp + (kk + 1) * 16); nb1 = *(const bf16x8*)(bp + 32 * 72 + (kk + 1) * 16);
            na0 = *(const bf16x8*)(ap + (kk + 1) * 16); na1 = *(const bf16x8*)(ap + 32 * 72 + (kk + 1) * 16);
            na2 = *(const bf16x8*)(ap + 64 * 72 + (kk + 1) * 16); na3 = *(const bf16x8*)(ap + 96 * 72 + (kk + 1) * 16);
          }
          acc[0][0] = __builtin_amdgcn_mfma_f32_32x32x16_bf16(a0, b0, acc[0][0], 0, 0, 0);
          acc[0][1] = __builtin_amdgcn_mfma_f32_32x32x16_bf16(a0, b1, acc[0][1], 0, 0, 0);
          acc[1][0] = __builtin_amdgcn_mfma_f32_32x32x16_bf16(a1, b0, acc[1][0], 0, 0, 0);
          acc[1][1] = __builtin_amdgcn_mfma_f32_32x32x16_bf16(a1, b1, acc[1][1], 0, 0, 0);
          acc[2][0] = __builtin_amdgcn_mfma_f32_32x32x16_bf16(a2, b0, acc[2][0], 0, 0, 0);
          acc[2][1] = __builtin_amdgcn_mfma_f32_32x32x16_bf16(a2, b1, acc[2][1], 0, 0, 0);
          acc[3][0] = __builtin_amdgcn_mfma_f32_32x32x16_bf16(a3, b0, acc[3][0], 0, 0, 0);
          acc[3][1] = __builtin_amdgcn_mfma_f32_32x32x16_bf16(a3, b1, acc[3][1], 0, 0, 0);
          if (kk < 3) { b0 = nb0; b1 = nb1; a0 = na0; a1 = na1; a2 = na2; a3 = na3; }
        }
      }
      if (kt + 1 < KT) {
        GLD_WAIT();
        sstore((kt + 1) & 1);
        if (kt + 2 < KT) gload(kt + 2);
      }
      __syncthreads();
    }
    const int hh = lane >> 5;
#pragma unroll
    for (int j = 0; j < 2; j++) {
      if (__builtin_amdgcn_readfirstlane(m0 + wm * 64 + j * 32) >= Mrows) continue;
      const int m = m0 + wm * 64 + j * 32 + (lane & 31);
      const bool mv = m < Mrows;
      const int mc = mv ? m : Mrows - 1;
      if (EPI == EPI_SWIGLU) {
        const float rs = rsqrtf(ss[(half ? 2 : 0) * MTOT + mc] * (1.f / DM) + EPS);
        bf16_t* act = (bf16_t*)(p.ws + W_ACT);
#pragma unroll
        for (int pr = 0; pr < 2; pr++)
#pragma unroll
          for (int g = 0; g < 4; g++) {
            float o[4];
#pragma unroll
            for (int e = 0; e < 4; e++) {
              float gt = acc[2 * pr][j][4 * g + e] * rs, up = acc[2 * pr + 1][j][4 * g + e] * rs;
              o[e] = siluf_(gt) * up;
            }
            int col = (2 * nt + wn) * 64 + pr * 32 + 8 * g + 4 * hh;
            if (mv) *(uint2*)(act + (size_t)m * DFF + col) = make_uint2(pack2(o[0], o[1]), pack2(o[2], o[3]));
          }
      } else {
        const int mg = half * MH + mc;
        const float rs = rsqrtf(ss[1 * MTOT + mg] * (1.f / DM) + EPS);
        bf16_t* z = (bf16_t*)(p.ws + W_Z);
        float* ba = (float*)(p.ws + W_BA);
#pragma unroll
        for (int i = 0; i < 4; i++)
#pragma unroll
          for (int g = 0; g < 4; g++) {
            const int n = n0 + wn * 128 + i * 32 + 8 * g + 4 * hh;
            float o0 = acc[i][j][4 * g + 0] * rs, o1 = acc[i][j][4 * g + 1] * rs, o2 = acc[i][j][4 * g + 2] * rs,
                  o3 = acc[i][j][4 * g + 3] * rs;
            if (mv && n < NIN) {
              *(uint2*)(z + (size_t)m * NIN + n) = make_uint2(pack2(o0, o1), pack2(o2, o3));
              if (n >= 4096 && n < 4112) *(float4*)(ba + (size_t)m * 16 + (n - 4096)) = make_float4(o0, o1, o2, o3);
            }
          }
      }
    }
  }
}

DEV void conv8(const bf16_t* __restrict__ Zb, int t, int zc, const float* __restrict__ cw, float (&o)[8]) {
#pragma unroll
  for (int e = 0; e < 8; e++) o[e] = 0.f;
#pragma unroll
  for (int j = 0; j < 4; j++) {
    int tt = t - 3 + j;
    if (tt >= 0) {
      uint4 raw = *(const uint4*)(Zb + (size_t)tt * NIN + zc);
      float4 w0 = *(const float4*)(cw + j * 3072 + zc), w1 = *(const float4*)(cw + j * 3072 + zc + 4);
      o[0] += bf2f(raw.x & 0xffff) * w0.x; o[1] += bf2f(raw.x >> 16) * w0.y;
      o[2] += bf2f(raw.y & 0xffff) * w0.z; o[3] += bf2f(raw.y >> 16) * w0.w;
      o[4] += bf2f(raw.z & 0xffff) * w1.x; o[5] += bf2f(raw.z >> 16) * w1.y;
      o[6] += bf2f(raw.w & 0xffff) * w1.z; o[7] += bf2f(raw.w >> 16) * w1.w;
    }
  }
#pragma unroll
  for (int e = 0; e < 8; e++) o[e] = siluf_(o[e]);
}

__device__ __forceinline__ void phase4(const P& p, char* smem) {
  const int tid = otid(), lane = tid & 63, wv = tid >> 6;
  char* gs = smem + wv * 18432;
  float* g_s = (float*)gs;
  float* be_s = g_s + 64;
  bf16_t* kn = (bf16_t*)(gs + 512);
  float* Mf = (float*)(gs + 512);
  const bf16_t* z = (const bf16_t*)(p.ws + W_Z);
  const float* ba = (const float*)(p.ws + W_BA);
  float* GB = (float*)(p.ws + W_GB);
  float* BB = (float*)(p.ws + W_BB);
  bf16_t* TTb = (bf16_t*)(p.ws + W_TT);
  for (int task = blockIdx.x * 8 + wv; task < 16 * NCHUNK; task += gridDim.x * 8) {
    const int unit = task / NCHUNK, n = task - unit * NCHUNK;
    const int bl = unit >> 3, h = unit & 7;
    const int tbase = n * 64 - 48;
    const bf16_t* Zb = z + (size_t)bl * TT * NIN;
    {
      int t = tbase + lane;
      float g = 0.f, be = 0.f;
      if (t >= 0) {
        size_t mrow = (size_t)bl * TT + t;
        float bp = ba[mrow * 16 + h], al = ba[mrow * 16 + 8 + h];
        g = -__expf(p.log_rate[h]) * softplusf_(al + p.dt_bias[h]);
        be = sigmoidf_(bp);
      }
#pragma unroll
      for (int d = 1; d < 64; d <<= 1) {
        float tq = __shfl_up(g, d);
        if (lane >= d) g += tq;
      }
      g_s[lane] = g;
      be_s[lane] = be;
      GB[(size_t)task * 64 + lane] = g;
      BB[(size_t)task * 64 + lane] = be;
    }
#pragma unroll 4
    for (int q = 0; q < 16; q++) {
      int id = lane + 64 * q;
      int row = id >> 4, cgp = id & 15;
      float o[8];
      conv8(Zb, tbase + row, 1024 + h * 128 + cgp * 8, p.conv_w, o);
      float sq = 0.f;
#pragma unroll
      for (int e = 0; e < 8; e++) sq += o[e] * o[e];
      sq = red16(sq);
      float sc = rsqrtf(sq + 1e-6f);
      *(uint4*)(kn + row * 136 + cgp * 8) =
          make_uint4(pack2(o[0] * sc, o[1] * sc), pack2(o[2] * sc, o[3] * sc), pack2(o[4] * sc, o[5] * sc),
                     pack2(o[6] * sc, o[7] * sc));
    }
    WAVE_FENCE();
    f32x16 kk[4];
#pragma unroll
    for (int tq = 0; tq < 4; tq++) {
#pragma unroll
      for (int r = 0; r < 16; r++) kk[tq][r] = 0.f;
      kk[tq] = mm32(kn + (tq >> 1) * 32 * 136, 136, kn + (tq & 1) * 32 * 136, 136, 128, kk[tq], lane);
    }
    WAVE_FENCE();
#pragma unroll
    for (int tq = 0; tq < 4; tq++) {
#pragma unroll
      for (int r = 0; r < 16; r++) {
        int c = (tq >> 1) * 32 + rowof(r, lane), sx = (tq & 1) * 32 + (lane & 31);
        float v = (c > sx) ? be_s[c] * kk[tq][r] * __expf(g_s[c] - g_s[sx]) : 0.f;
        Mf[c * 68 + sx] = v;
      }
    }
    WAVE_FENCE();
    bf16_t* Tg = TTb + (size_t)task * 4096;
    {
      float x[64];
#pragma unroll
      for (int c = 0; c < 64; c++) x[c] = 0.f;
#pragma unroll
      for (int c = 0; c < 64; c++) {
        float a0 = (lane == c) ? 1.f : 0.f, a1 = 0.f, a2 = 0.f, a3 = 0.f;
#pragma unroll
        for (int s4 = 0; s4 < (c + 3) / 4; s4++) {
          const float4 mv = *(const float4*)(Mf + c * 68 + s4 * 4);
          a0 -= mv.x * x[s4 * 4 + 0];
          a1 -= mv.y * x[s4 * 4 + 1];
          a2 -= mv.z * x[s4 * 4 + 2];
          a3 -= mv.w * x[s4 * 4 + 3];
        }
        x[c] = (a0 + a1) + (a2 + a3);
        Tg[c * 64 + lane] = f2bf(x[c]);
      }
    }
    WAVE_FENCE();
  }
  bf16_t* sg = (bf16_t*)(p.ws + W_SG);
  for (int idx = blockIdx.x * 512 + tid; idx < MH * 24; idx += gridDim.x * 512) {
    const int m = idx / 24, jg = idx - m * 24;
    uint4 outv = make_uint4(0, 0, 0, 0);
    if (jg < 20) {
      const int t = m % TT;
      const bf16_t* src = z + (size_t)m * NIN + ZRW + 3200 + jg * 8;
      const uint4 cu = *(const uint4*)src;
      uint4 pr = make_uint4(0, 0, 0, 0);
      if (t > 0) pr = *(const uint4*)(src - NIN);
      const float4 m0 = *(const float4*)(p.mu + 3200 + jg * 8), m1 = *(const float4*)(p.mu + 3200 + jg * 8 + 4);
      const float mm[8] = {m0.x, m0.y, m0.z, m0.w, m1.x, m1.y, m1.z, m1.w};
      const uint32_t cw[4] = {cu.x, cu.y, cu.z, cu.w}, pw[4] = {pr.x, pr.y, pr.z, pr.w};
      float v[8];
#pragma unroll
      for (int e = 0; e < 8; e++) {
        float c = bf2f((e & 1) ? (cw[e >> 1] >> 16) : (cw[e >> 1] & 0xffff));
        float q = bf2f((e & 1) ? (pw[e >> 1] >> 16) : (pw[e >> 1] & 0xffff));
        v[e] = sigmoidf_(c + (q - c) * mm[e]);
      }
      outv = make_uint4(pack2(v[0], v[1]), pack2(v[2], v[3]), pack2(v[4], v[5]), pack2(v[6], v[7]));
    }
    *(uint4*)(sg + (size_t)m * 192 + jg * 8) = outv;
  }
  bf16_t* xwa = (bf16_t*)(p.ws + W_XWA);
  for (int idx = blockIdx.x * 512 + tid; idx < MH * 16; idx += gridDim.x * 512) {
    const int m = idx >> 4, jg = idx & 15;
    const int t = m % TT;
    const bf16_t* src = z + (size_t)m * NIN + ZRW + 3072 + jg * 8;
    const uint4 cu = *(const uint4*)src;
    uint4 pr = make_uint4(0, 0, 0, 0);
    if (t > 0) pr = *(const uint4*)(src - NIN);
    const float4 m0 = *(const float4*)(p.mu + 3072 + jg * 8), m1 = *(const float4*)(p.mu + 3072 + jg * 8 + 4);
    const float mm[8] = {m0.x, m0.y, m0.z, m0.w, m1.x, m1.y, m1.z, m1.w};
    const uint32_t cw[4] = {cu.x, cu.y, cu.z, cu.w}, pw[4] = {pr.x, pr.y, pr.z, pr.w};
    float v[8];
#pragma unroll
    for (int e = 0; e < 8; e++) {
      float c = bf2f((e & 1) ? (cw[e >> 1] >> 16) : (cw[e >> 1] & 0xffff));
      float q = bf2f((e & 1) ? (pw[e >> 1] >> 16) : (pw[e >> 1] & 0xffff));
      float x = c + (q - c) * mm[e];
      if (jg < 8) { float ex = __expf(2.f * x); x = 1.f - 2.f * rcpf_(ex + 1.f); }
      v[e] = x;
    }
    *(uint4*)(xwa + (size_t)m * 128 + jg * 8) = make_uint4(pack2(v[0], v[1]), pack2(v[2], v[3]), pack2(v[4], v[5]), pack2(v[6], v[7]));
  }
}

constexpr int RLD = 68;
constexpr int RW_NC = (TT + 31) / 32;
constexpr int RW_BUF = (5 * 32 * RLD + 32 * 16 + 32) * 4;
DEV int rw_rel(int ch, int h, int rq) {
  return ch < 8 ? h * 64 + ch * 8
       : ch < 16 ? 1024 + h * 64 + (ch - 8) * 8
       : ch < 24 ? 3072 + (ch - 16) * 8
       : ch < 32 ? 3136 + (ch - 24) * 8
                 : 2048 + h * 64 + rq * 16 + (ch - 32) * 8;
}
DEV float wave_sum_bcast(float v) {
  v = red16(v);
  float r0 = __int_as_float(__builtin_amdgcn_readlane(__float_as_int(v), 0));
  float r1 = __int_as_float(__builtin_amdgcn_readlane(__float_as_int(v), 16));
  float r2 = __int_as_float(__builtin_amdgcn_readlane(__float_as_int(v), 32));
  float r3 = __int_as_float(__builtin_amdgcn_readlane(__float_as_int(v), 48));
  return (r0 + r1) + (r2 + r3);
}
__device__ __forceinline__ void rwkv_block(const P& p, char* smem, int unit, int rq) {
  const int tid = otid(), lane = tid & 63;
  const int wv = __builtin_amdgcn_readfirstlane(tid >> 6);
  const int bl = unit >> 4, h = unit & 15;
  bf16_t* wupT = (bf16_t*)smem;
  bf16_t* aupT = wupT + 64 * 72;
  bf16_t* Xw = aupT + 64 * 72;
  bf16_t* Xa = Xw + 32 * 72;
  bf16_t* raw_all = Xa + 32 * 72;
  float* mu_s = (float*)(raw_all + 4 * 9 * 272);
  float* y_all = mu_s + 272;
  char* obuf = (char*)(y_all + 2 * 512);
  for (int e = tid; e < 4096; e += 512) {
    int j = e >> 6, c = e & 63;
    wupT[c * 72 + j] = f2bf(p.w_up[(size_t)j * DM + h * 64 + c]);
    aupT[c * 72 + j] = f2bf(p.a_up[(size_t)j * DM + h * 64 + c]);
  }
  for (int e = tid; e < 2 * 32 * 72; e += 512) Xw[e] = 0;
  if (tid < 272) mu_s[tid] = p.mu[rw_rel(tid >> 3, h, rq) + (tid & 7)];
  const bf16_t* Zb = (const bf16_t*)(p.ws + W_Z) + (size_t)bl * TT * NIN + ZRW;
  bf16_t* YB = (bf16_t*)(p.ws + W_YB);
  bf16_t* BON = (bf16_t*)(p.ws + W_BON);
  float* YST = (float*)(p.ws + W_YST);
  __syncthreads();
  if (wv >= 4) {
    const int pw = wv - 4;
    bf16_t* raw_s = raw_all + pw * 9 * 144;
    const bf16_t* XWA = (const bf16_t*)(p.ws + W_XWA) + (size_t)bl * TT * 128;
    uint4 pre[5];
    auto prefetch = [&](int t0) {
#pragma unroll
      for (int q = 0; q < 5; q++) {
        int item = lane + 64 * q;
        pre[q] = make_uint4(0, 0, 0, 0);
        if (item < 162) {
          int row = item / 18, c18 = item - row * 18;
          int t = t0 + pw * 8 - 1 + row;
          if (t >= 0 && t < TT) pre[q] = *(const uint4*)(Zb + (size_t)t * NIN + rw_rel(c18 < 16 ? c18 : 16 + c18, h, rq));
        } else if (item < 162 + 128) {
          int j = item - 162;
          int t = t0 + pw * 8 + (j >> 4);
          if (t < TT) pre[q] = *(const uint4*)(XWA + (size_t)t * 128 + (j & 15) * 8);
        }
      }
    };
    prefetch(0);
    float cst[5][8];
#pragma unroll
    for (int e = 0; e < 8; e++) {
      const int ch = h * 64 + (lane & 7) * 8 + e;
      cst[0][e] = p.w0[ch]; cst[1][e] = p.a0[ch]; cst[2][e] = p.k_k[ch]; cst[3][e] = p.k_a[ch]; cst[4][e] = p.r_k[ch];
    }
    for (int i = 0; i < RW_NC + 2; i++) {
      float* bufp = (float*)(obuf + (i & 1) * RW_BUF);
      float* rs_s = bufp;
      float* ks_s = rs_s + 32 * RLD;
      float* w_s = ks_s + 32 * RLD;
      float* a_s = w_s + 32 * RLD;
      float* na_s = a_s + 32 * RLD;
      float* vs_s = na_s + 32 * RLD;
      float* rk_s = vs_s + 512;
      if (i >= 2) {
        const float* y_s = y_all + (i & 1) * 512;
        const int t0o = (i - 2) * 32;
#pragma unroll
        for (int q = 0; q < 2; q++) {
          int item = lane + 64 * q;
          int tt = pw * 8 + (item >> 4), rl = item & 15;
          int t = t0o + tt;
          float y = y_s[tt * 16 + rl];
          float sy = red16(y), sy2 = red16(y * y);
          if (t < TT) {
            size_t mrow = (size_t)bl * TT + t;
            int col = h * 64 + rq * 16 + rl;
            YB[mrow * DM + col] = f2bf(y);
            BON[mrow * DM + col] = f2bf(rk_s[tt] * vs_s[tt * 16 + rl]);
            if (rl == 0) {
              float* d = YST + ((mrow * 16 + h) * 4 + rq) * 2;
              d[0] = sy;
              d[1] = sy2;
            }
          }
        }
        WAVE_FENCE();
      }
      if (i < RW_NC) {
        const int t0 = i * 32;
#pragma unroll
        for (int q = 0; q < 5; q++) {
          int item = lane + 64 * q;
          if (item < 162) {
            int row = item / 18, c18 = item - row * 18;
            *(uint4*)(raw_s + row * 144 + c18 * 8) = pre[q];
          } else if (item < 162 + 128) {
            int j = item - 162;
            int c16 = j & 15;
            *(uint4*)((c16 < 8 ? Xw : Xa) + (pw * 8 + (j >> 4)) * 72 + (c16 & 7) * 8) = pre[q];
          }
        }
        WAVE_FENCE();
        prefetch(t0 + 32);
        {
          auto shift8 = [&](int tl, int c18, int chm, float (&v)[8]) {
            uint4 cu = *(const uint4*)(raw_s + (tl + 1) * 144 + c18 * 8);
            uint4 pr = *(const uint4*)(raw_s + tl * 144 + c18 * 8);
            uint32_t cw[4] = {cu.x, cu.y, cu.z, cu.w}, pwd[4] = {pr.x, pr.y, pr.z, pr.w};
            float4 m0 = *(const float4*)(mu_s + chm * 8), m1 = *(const float4*)(mu_s + chm * 8 + 4);
            const float mm[8] = {m0.x, m0.y, m0.z, m0.w, m1.x, m1.y, m1.z, m1.w};
#pragma unroll
            for (int e = 0; e < 8; e++) {
              float c = bf2f((e & 1) ? (cw[e >> 1] >> 16) : (cw[e >> 1] & 0xffff));
              float q = bf2f((e & 1) ? (pwd[e >> 1] >> 16) : (pwd[e >> 1] & 0xffff));
              v[e] = c + (q - c) * mm[e];
            }
          };
          const int tl = lane >> 3, c8 = lane & 7, tt = pw * 8 + tl;
          float v[8];
          shift8(tl, c8, c8, v);
          *(float4*)(rs_s + tt * RLD + c8 * 8) = make_float4(v[0], v[1], v[2], v[3]);
          *(float4*)(rs_s + tt * RLD + c8 * 8 + 4) = make_float4(v[4], v[5], v[6], v[7]);
          shift8(tl, 8 + c8, 8 + c8, v);
          *(float4*)(ks_s + tt * RLD + c8 * 8) = make_float4(v[0], v[1], v[2], v[3]);
          *(float4*)(ks_s + tt * RLD + c8 * 8 + 4) = make_float4(v[4], v[5], v[6], v[7]);
          if (lane < 16) {
            const int tl2 = lane >> 1, c2 = lane & 1;
            shift8(tl2, 16 + c2, 32 + c2, v);
            float* d = vs_s + (pw * 8 + tl2) * 16 + c2 * 8;
            *(float4*)d = make_float4(v[0], v[1], v[2], v[3]);
            *(float4*)(d + 4) = make_float4(v[4], v[5], v[6], v[7]);
          }
        }
        WAVE_FENCE();
#pragma unroll 1
        for (int tile = 0; tile < 4; tile++) {
          const int mat = tile >> 1, ct = tile & 1;
          f32x16 acc;
#pragma unroll
          for (int r = 0; r < 16; r++) acc[r] = 0.f;
          acc = mm32((mat ? aupT : wupT) + ct * 32 * 72, 72, mat ? Xa : Xw, 72, 64, acc, lane);
          const int t = lane & 31;
          if ((t >> 3) == pw) {
#pragma unroll
            for (int g = 0; g < 4; g++) {
              const int c0 = ct * 32 + 8 * g + 4 * (lane >> 5);
              float o[4] = {acc[4 * g], acc[4 * g + 1], acc[4 * g + 2], acc[4 * g + 3]};
              *(float4*)((mat ? a_s : w_s) + t * RLD + c0) = make_float4(o[0], o[1], o[2], o[3]);
            }
          }
        }
        WAVE_FENCE();
        {
          const int tl = lane >> 3, c8 = lane & 7, tt = pw * 8 + tl;
          float* kp_ = ks_s + tt * RLD + c8 * 8;
          float* a_ = a_s + tt * RLD + c8 * 8;
          float* w_ = w_s + tt * RLD + c8 * 8;
          const float* r_ = rs_s + tt * RLD + c8 * 8;
          float* n_ = na_s + tt * RLD + c8 * 8;
          float kv[8], av[8], wv8[8], rv[8];
          *(float4*)&kv[0] = *(const float4*)kp_; *(float4*)&kv[4] = *(const float4*)(kp_ + 4);
          *(float4*)&av[0] = *(const float4*)a_; *(float4*)&av[4] = *(const float4*)(a_ + 4);
          *(float4*)&wv8[0] = *(const float4*)w_; *(float4*)&wv8[4] = *(const float4*)(w_ + 4);
          *(float4*)&rv[0] = *(const float4*)r_; *(float4*)&rv[4] = *(const float4*)(r_ + 4);
          float kk[8], ssq = 0.f, rkp = 0.f;
#pragma unroll
          for (int e = 0; e < 8; e++) {
            av[e] = sigmoidf_(av[e] + cst[1][e]);
            wv8[e] = __expf(-0.6065306597126334f * sigmoidf_(wv8[e] + cst[0][e]));
            kk[e] = kv[e] * cst[2][e];
            ssq += kk[e] * kk[e];
            kv[e] = kv[e] * (1.f + (av[e] - 1.f) * cst[3][e]);
            rkp += rv[e] * kv[e] * cst[4][e];
          }
          ssq += dpp_f<0xB1>(ssq); ssq += dpp_f<0x4E>(ssq); ssq += dpp_f<0x141>(ssq);
          rkp += dpp_f<0xB1>(rkp); rkp += dpp_f<0x4E>(rkp); rkp += dpp_f<0x141>(rkp);
          const float sc = rsqrtf(ssq + 1e-6f);
#pragma unroll
          for (int e = 0; e < 8; e++) { kk[e] *= sc; av[e] *= kk[e]; kk[e] = -kk[e]; }
          *(float4*)n_ = make_float4(kk[0], kk[1], kk[2], kk[3]); *(float4*)(n_ + 4) = make_float4(kk[4], kk[5], kk[6], kk[7]);
          *(float4*)a_ = make_float4(av[0], av[1], av[2], av[3]); *(float4*)(a_ + 4) = make_float4(av[4], av[5], av[6], av[7]);
          *(float4*)kp_ = make_float4(kv[0], kv[1], kv[2], kv[3]); *(float4*)(kp_ + 4) = make_float4(kv[4], kv[5], kv[6], kv[7]);
          *(float4*)w_ = make_float4(wv8[0], wv8[1], wv8[2], wv8[3]); *(float4*)(w_ + 4) = make_float4(wv8[4], wv8[5], wv8[6], wv8[7]);
          if (c8 == 0) rk_s[tt] = rkp;
        }
      }
      __syncthreads();
    }
  } else {
    float s0 = 0.f, s1 = 0.f, s2 = 0.f, s3 = 0.f;
    const int row_l = (tid >> 4) & 15, kq = tid & 15;
    for (int i = 0; i < RW_NC + 2; i++) {
      if (i >= 1 && i <= RW_NC) {
        typedef float f4v __attribute__((ext_vector_type(4)));
        typedef const __attribute__((address_space(3))) float* ldsf;
        typedef __attribute__((address_space(3))) float* ldsfw;
        const float* bufp = (const float*)(obuf + ((i - 1) & 1) * RW_BUF);
        ldsf rs_s = (ldsf)(bufp + kq * 4);
        ldsf ks_s = rs_s + 32 * RLD;
        ldsf w_s = ks_s + 32 * RLD;
        ldsf a_s = w_s + 32 * RLD;
        ldsf na_s = a_s + 32 * RLD;
        ldsf vs_s = (ldsf)(bufp + 5 * 32 * RLD + row_l);
        ldsfw y_s = (ldsfw)(kq == 0 ? (y_all + ((i - 1) & 1) * 512 + row_l) : (float*)(smem + 143808) + tid);
        asm volatile("" : "+v"(rs_s), "+v"(ks_s), "+v"(w_s), "+v"(a_s), "+v"(na_s), "+v"(vs_s), "+v"(y_s));
        typedef float v2f __attribute__((ext_vector_type(2)));
        f4v a4 = *(const __attribute__((address_space(3))) f4v*)(na_s), w4 = *(const __attribute__((address_space(3))) f4v*)(w_s), b4 = *(const __attribute__((address_space(3))) f4v*)(a_s),
               k4 = *(const __attribute__((address_space(3))) f4v*)(ks_s), r4 = *(const __attribute__((address_space(3))) f4v*)(rs_s);
        float vv = vs_s[0];
        v2f s01 = {s0, s1}, s23 = {s2, s3};
#pragma unroll 8
        for (int tt = 0; tt < 32; tt++) {
          const int tn = (tt + 1) & 31;
          f4v a4n = *(const __attribute__((address_space(3))) f4v*)(na_s + tn * RLD), w4n = *(const __attribute__((address_space(3))) f4v*)(w_s + tn * RLD),
                 b4n = *(const __attribute__((address_space(3))) f4v*)(a_s + tn * RLD), k4n = *(const __attribute__((address_space(3))) f4v*)(ks_s + tn * RLD),
                 r4n = *(const __attribute__((address_space(3))) f4v*)(rs_s + tn * RLD);
          float vvn = vs_s[tn * 16];
          const v2f a01 = {a4.x, a4.y}, a23 = {a4.z, a4.w}, w01 = {w4.x, w4.y}, w23 = {w4.z, w4.w};
          const v2f b01 = {b4.x, b4.y}, b23 = {b4.z, b4.w}, k01 = {k4.x, k4.y}, k23 = {k4.z, k4.w};
          const v2f r01 = {r4.x, r4.y}, r23 = {r4.z, r4.w}, vv2 = {vv, vv};
          v2f pd = s01 * a01 + s23 * a23;
          v2f t01 = s01 * w01 + vv2 * k01, t23 = s23 * w23 + vv2 * k23;
          float sa = red16(pd.x + pd.y);
          const v2f sa2 = {sa, sa};
          s01 = t01 + sa2 * b01;
          s23 = t23 + sa2 * b23;
          v2f py = s01 * r01 + s23 * r23;
          float y = red16(py.x + py.y);
          y_s[tt * 16] = y;
          a4 = a4n; w4 = w4n; b4 = b4n; k4 = k4n; r4 = r4n; vv = vvn;
        }
        s0 = s01.x; s1 = s01.y; s2 = s23.x; s3 = s23.y;
      }
      __syncthreads();
    }
  }
  __syncthreads();
}

__device__ __forceinline__ void delta_block(const P& p, char* smem, int unit, int sl) {
  const int tid0 = otid();
  const int bl = unit >> 3, h = unit & 7;
  float* gc_s = (float*)smem;
  float* be_s = gc_s + 64;
  bf16_t* qn = (bf16_t*)(smem + 512);
  bf16_t* kn = qn + 64 * 136;
  bf16_t* wk = kn + 64 * 136;
  bf16_t* knT = wk + 64 * 136;
  bf16_t* ktT = knT + 128 * 72;
  bf16_t* Tb = ktT + 128 * 72;
  bf16_t* Tbg = Tb + 64 * 72;
  bf16_t* attn = Tbg + 64 * 72;
  bf16_t* vT = attn + 64 * 72;
  bf16_t* vnT = vT + 32 * 72;
  bf16_t* ST = vnT + 32 * 72;
  const bf16_t* z = (const bf16_t*)(p.ws + W_Z);
  const bf16_t* Zb = z + (size_t)bl * TT * NIN;
  const float* GB = (const float*)(p.ws + W_GB);
  const float* BB = (const float*)(p.ws + W_BB);
  const bf16_t* TTb = (const bf16_t*)(p.ws + W_TT);
  bf16_t* OA = (bf16_t*)(p.ws + W_OA);
  float* OST = (float*)(p.ws + W_OST);
  float* cw_s = (float*)(ST + 32 * 136);
  bf16_t* o_s = (bf16_t*)(cw_s + 4 * 288);
  for (int e = tid0; e < 32 * 136; e += 512) ST[e] = 0;
  for (int e = tid0; e < 4 * 288; e += 512) {
    int j = e / 288, c = e - j * 288;
    int zc = c < 128 ? h * 128 + c : (c < 256 ? 1024 + h * 128 + (c - 128) : 2048 + h * 128 + sl * 32 + (c - 256));
    cw_s[e] = p.conv_w[j * 3072 + zc];
  }
  uint4 praw[7], vraw[7];
  const int c_role = tid0 >> 8, c_rg = (tid0 & 255) >> 4, c_cgp = tid0 & 15;
  const int c_zc = (c_role ? 1024 : 0) + h * 128 + c_cgp * 8;
  const int v_rg = tid0 >> 2, v_zc = 2048 + h * 128 + sl * 32 + (tid0 & 3) * 8;
  auto prefetch_raw = [&](int n) {
    const int tb = n * 64 - 48;
#pragma unroll
    for (int i = 0; i < 7; i++) {
      int t = tb + 4 * c_rg - 3 + i;
      praw[i] = make_uint4(0, 0, 0, 0);
      if (n < NCHUNK && t >= 0) praw[i] = *(const uint4*)(Zb + (size_t)t * NIN + c_zc);
      int tv = tb + 4 * v_rg - 3 + i;
      vraw[i] = make_uint4(0, 0, 0, 0);
      if (n < NCHUNK && tid0 < 64 && tv >= 0) vraw[i] = *(const uint4*)(Zb + (size_t)tv * NIN + v_zc);
    }
  };
  uint4 Tpre = make_uint4(0, 0, 0, 0);
  float gpre = 0.f, bpre = 0.f;
  auto prefetch_small = [&](int n) {
    if (n < NCHUNK) {
      const size_t task = (size_t)unit * NCHUNK + n;
      Tpre = *(const uint4*)(TTb + task * 4096 + (tid0 >> 3) * 64 + (tid0 & 7) * 8);
      if (tid0 < 64) { gpre = GB[task * 64 + tid0]; bpre = BB[task * 64 + tid0]; }
    }
  };
  auto flush_o = [&](int n) {
    const int c = tid0 >> 3, part = tid0 & 7;
    const int t = n * 64 - 48 + c;
    uint2 raw = *(const uint2*)(o_s + c * 36 + part * 4);
    float a0 = bf2f(raw.x & 0xffff), a1 = bf2f(raw.x >> 16), a2 = bf2f(raw.y & 0xffff), a3 = bf2f(raw.y >> 16);
    float sq = a0 * a0 + a1 * a1 + a2 * a2 + a3 * a3;
    sq += dpp_f<0xB1>(sq); sq += dpp_f<0x4E>(sq); sq += dpp_f<0x141>(sq);
    if (t >= 0) {
      size_t mrow = (size_t)bl * TT + t;
      *(uint2*)(OA + mrow * DM + h * 128 + sl * 32 + part * 4) = raw;
      if (part == 0) OST[(mrow * 8 + h) * 4 + sl] = sq;
    }
  };
  prefetch_raw(0);
  prefetch_small(0);
  f32x16 R;
#pragma unroll
  for (int r = 0; r < 16; r++) R[r] = 0.f;
  __syncthreads();
  for (int n = 0; n < NCHUNK; n++) {
    int tid = tid0;
    asm volatile("" : "+v"(tid));
    int lane = tid & 63, wv = tid >> 6;
    const int task = unit * NCHUNK + n;
    const int tbase = n * 64 - 48;
    if (tid < 64) { gc_s[tid] = gpre; be_s[tid] = bpre; }
    if (n > 0) flush_o(n - 1);
    __syncthreads();
    const float gl = gc_s[63];
    {
      const int cbase = c_role * 128 + c_cgp * 8;
      float cwv[4][8];
#pragma unroll
      for (int j = 0; j < 4; j++) {
        float4 w0 = *(const float4*)(cw_s + j * 288 + cbase), w1 = *(const float4*)(cw_s + j * 288 + cbase + 4);
        cwv[j][0] = w0.x; cwv[j][1] = w0.y; cwv[j][2] = w0.z; cwv[j][3] = w0.w;
        cwv[j][4] = w1.x; cwv[j][5] = w1.y; cwv[j][6] = w1.z; cwv[j][7] = w1.w;
      }
      uint32_t kpk[4][4];
#pragma unroll
      for (int rr = 0; rr < 4; rr++)
#pragma unroll
        for (int e = 0; e < 4; e++) kpk[rr][e] = 0u;
#pragma unroll
      for (int rr = 0; rr < 4; rr++) {
        const int row = 4 * c_rg + rr;
        float o[8];
#pragma unroll
        for (int e = 0; e < 8; e++) o[e] = 0.f;
#pragma unroll
        for (int j = 0; j < 4; j++) {
          const uint4 rw = praw[rr + j];
          const uint32_t w[4] = {rw.x, rw.y, rw.z, rw.w};
#pragma unroll
          for (int e = 0; e < 8; e++) o[e] += bf2f((e & 1) ? (w[e >> 1] >> 16) : (w[e >> 1] & 0xffff)) * cwv[j][e];
        }
        float s = 0.f;
#pragma unroll
        for (int e = 0; e < 8; e++) { o[e] = siluf_(o[e]); s += o[e] * o[e]; }
        s = red16(s);
        float sc = rsqrtf(s + 1e-6f);
        if (c_role == 0) {
          sc *= 0.08838834764831845f;
          *(uint4*)(qn + row * 136 + c_cgp * 8) =
              make_uint4(pack2(o[0] * sc, o[1] * sc), pack2(o[2] * sc, o[3] * sc), pack2(o[4] * sc, o[5] * sc),
                         pack2(o[6] * sc, o[7] * sc));
        } else {
          uint32_t pk[4];
#pragma unroll
          for (int e = 0; e < 4; e++) pk[e] = pack2(o[2 * e] * sc, o[2 * e + 1] * sc);
          *(uint4*)(kn + row * 136 + c_cgp * 8) = make_uint4(pk[0], pk[1], pk[2], pk[3]);
#pragma unroll
          for (int e = 0; e < 4; e++) kpk[rr][e] = pk[e];
        }
      }
      if (c_role == 1) {
#pragma unroll
        for (int e = 0; e < 8; e++) {
          const int sh = (e & 1) * 16;
          const uint32_t r0 = (kpk[0][e >> 1] >> sh) & 0xffffu, r1 = (kpk[1][e >> 1] >> sh) & 0xffffu,
                         r2 = (kpk[2][e >> 1] >> sh) & 0xffffu, r3 = (kpk[3][e >> 1] >> sh) & 0xffffu;
          *(uint2*)(knT + (c_cgp * 8 + e) * 72 + 4 * c_rg) = make_uint2(r0 | (r1 << 16), r2 | (r3 << 16));
        }
      }
      if (tid < 64) {
        const int vb = 256 + (tid & 3) * 8;
        bf16_t vpk[4][8];
#pragma unroll
        for (int rr = 0; rr < 4; rr++) {
          float o[8];
#pragma unroll
          for (int e = 0; e < 8; e++) o[e] = 0.f;
#pragma unroll
          for (int j = 0; j < 4; j++) {
            const uint4 rw = vraw[rr + j];
            const uint32_t w[4] = {rw.x, rw.y, rw.z, rw.w};
#pragma unroll
            for (int e = 0; e < 8; e++)
              o[e] += bf2f((e & 1) ? (w[e >> 1] >> 16) : (w[e >> 1] & 0xffff)) * cw_s[j * 288 + vb + e];
          }
#pragma unroll
          for (int e = 0; e < 8; e++) vpk[rr][e] = f2bf(siluf_(o[e]));
        }
#pragma unroll
        for (int e = 0; e < 8; e++)
          *(uint2*)(vT + ((tid & 3) * 8 + e) * 72 + 4 * v_rg) =
              make_uint2((uint32_t)vpk[0][e] | ((uint32_t)vpk[1][e] << 16), (uint32_t)vpk[2][e] | ((uint32_t)vpk[3][e] << 16));
      }
      prefetch_raw(n + 1);
    }
    {
      int c = tid >> 3, sb = (tid & 7) * 8;
      uint4 raw = Tpre;
      uint32_t w[4] = {raw.x, raw.y, raw.z, raw.w};
      uint32_t ob[4], og[4];
#pragma unroll
      for (int e = 0; e < 4; e++) {
        float t0v = bf2f(w[e] & 0xffff), t1v = bf2f(w[e] >> 16);
        int s0i = sb + 2 * e, s1i = s0i + 1;
        float b0 = be_s[s0i], b1 = be_s[s1i];
        ob[e] = pack2(t0v * b0, t1v * b1);
        og[e] = pack2(t0v * b0 * __expf(gc_s[s0i]), t1v * b1 * __expf(gc_s[s1i]));
      }
      *(uint4*)(Tb + c * 72 + sb) = make_uint4(ob[0], ob[1], ob[2], ob[3]);
      *(uint4*)(Tbg + c * 72 + sb) = make_uint4(og[0], og[1], og[2], og[3]);
      prefetch_small(n + 1);
    }
    __syncthreads();
    tid = tid0; asm volatile("" : "+v"(tid)); lane = tid & 63; wv = tid >> 6;
    {
      const int ta = wv == 0 ? 0 : wv == 1 ? 4 : wv == 2 ? 1 : wv == 3 ? 5 : wv == 5 ? 3 : -1;
      const int tb2 = wv == 2 ? 2 : wv == 3 ? 6 : wv == 5 ? 7 : -1;
#pragma unroll 1
      for (int q = 0; q < 2; q++) {
        const int t8 = q == 0 ? ta : tb2;
        if (t8 >= 0) {
          const int ti = t8 >> 2, tj = t8 & 3;
          f32x16 acc;
#pragma unroll
          for (int r = 0; r < 16; r++) acc[r] = 0.f;
          acc = mm32(Tbg + ti * 32 * 72, 72, knT + tj * 32 * 72, 72, 64, acc, lane);
#pragma unroll
          for (int r = 0; r < 16; r++) wk[(ti * 32 + rowof(r, lane)) * 136 + tj * 32 + (lane & 31)] = f2bf(acc[r]);
        }
      }
    }
    if (wv == 5) {
#pragma unroll
      for (int r = 0; r < 16; r++) attn[rowof(r, lane) * 72 + 32 + (lane & 31)] = 0;
    } else if (wv >= 4) {
      const int ci = (wv - 4) >> 1, si = (wv - 4) & 1;
      f32x16 acc;
#pragma unroll
      for (int r = 0; r < 16; r++) acc[r] = 0.f;
      acc = mm32(qn + ci * 32 * 136, 136, kn + si * 32 * 136, 136, 128, acc, lane);
#pragma unroll
      for (int r = 0; r < 16; r++) {
        int c = ci * 32 + rowof(r, lane), s = si * 32 + (lane & 31);
        float v = (c >= s) ? acc[r] * __expf(gc_s[c] - gc_s[s]) : 0.f;
        attn[c * 72 + s] = f2bf(v);
      }
    } else if (wv < 2) {
#pragma unroll
      for (int r = 0; r < 16; r++) R[r] = 0.f;
      R = mm32(Tb + wv * 32 * 72, 72, vT, 72, 64, R, lane);
    }
    __syncthreads();
    tid = tid0; asm volatile("" : "+v"(tid)); lane = tid & 63; wv = tid >> 6;
    if (wv < 2) {
      f32x16 acc;
#pragma unroll
      for (int r = 0; r < 16; r++) acc[r] = 0.f;
      acc = mm32(wk + wv * 32 * 136, 136, ST, 136, 128, acc, lane);
      const int dv = lane & 31;
#pragma unroll
      for (int g = 0; g < 4; g++) {
        int c0 = wv * 32 + 8 * g + 4 * (lane >> 5);
        float v0 = R[4 * g] - acc[4 * g], v1 = R[4 * g + 1] - acc[4 * g + 1], v2 = R[4 * g + 2] - acc[4 * g + 2],
              v3 = R[4 * g + 3] - acc[4 * g + 3];
        *(uint2*)(vnT + dv * 72 + c0) = make_uint2(pack2(v0, v1), pack2(v2, v3));
        *(uint2*)(ktT + dv * 72 + c0) =
            make_uint2(pack2(v0 * __expf(gl - gc_s[c0]), v1 * __expf(gl - gc_s[c0 + 1])),
                       pack2(v2 * __expf(gl - gc_s[c0 + 2]), v3 * __expf(gl - gc_s[c0 + 3])));
      }
    } else if (wv < 4) {
      const int ti = wv - 2;
#pragma unroll
      for (int r = 0; r < 16; r++) R[r] = 0.f;
      R = mm32(qn + ti * 32 * 136, 136, ST, 136, 128, R, lane);
#pragma unroll
      for (int r = 0; r < 16; r++) R[r] *= __expf(gc_s[ti * 32 + rowof(r, lane)]);
    }
    __syncthreads();
    tid = tid0; asm volatile("" : "+v"(tid)); lane = tid & 63; wv = tid >> 6;
    if (wv >= 2 && wv < 4) {
      const int ti = wv - 2;
      R = mm32(attn + ti * 32 * 72, 72, vnT, 72, 64, R, lane);
      const int dv = lane & 31;
#pragma unroll
      for (int r = 0; r < 16; r++) o_s[(ti * 32 + rowof(r, lane)) * 36 + dv] = f2bf(R[r]);
    } else if (wv >= 4) {
      const int di = wv - 4;
      const float eg = __expf(gl);
#pragma unroll
      for (int r = 0; r < 16; r++) R[r] *= eg;
      R = mm32(knT + di * 32 * 72, 72, ktT, 72, 64, R, lane);
      const int dv = lane & 31;
#pragma unroll
      for (int g = 0; g < 4; g++) {
        int d0 = di * 32 + 8 * g + 4 * (lane >> 5);
        *(uint2*)(ST + dv * 136 + d0) =
            make_uint2(pack2(R[4 * g], R[4 * g + 1]), pack2(R[4 * g + 2], R[4 * g + 3]));
      }
    }
    __syncthreads();
  }
  flush_o(NCHUNK - 1);
  __syncthreads();
}

__device__ __forceinline__ void phase_final(const P& p) {
  const float* h3 = (const float*)(p.ws + W_H3);
  const float* ss = (const float*)(p.ws + W_SS) + 3 * MTOT;
  const int tid_ = otid();
  const int lane = tid_ & 63, wv = tid_ >> 6;
  for (int r = blockIdx.x * 8 + wv; r < NB * SEQ; r += gridDim.x * 8) {
    int b = r / SEQ, t = r - b * SEQ;
    int m = b * TT + NMETA + t;
    float rs = rsqrtf(ss[m] * (1.f / DM) + EPS);
    float4 v4[4], g4[4];
#pragma unroll
    for (int q = 0; q < 4; q++) {
      int c = q * 256 + lane * 4;
      v4[q] = *(const float4*)(h3 + (size_t)m * DM + c);
      g4[q] = *(const float4*)(p.final_norm + c);
    }
#pragma unroll
    for (int q = 0; q < 4; q++) {
      int c = q * 256 + lane * 4;
      float4 v = v4[q], g = g4[q];
      *(float4*)(p.out + (size_t)r * DM + c) = make_float4(v.x * rs * g.x, v.y * rs * g.y, v.z * rs * g.z, v.w * rs * g.w);
    }
  }
}


DEV void grid_barrier(unsigned* bar, unsigned& epoch) {
  __syncthreads();
  if (threadIdx.x == 0) {
    epoch++;
    const unsigned g = blockIdx.x & 7u;
    const unsigned gsize = (gridDim.x >> 3) + ((gridDim.x & 7u) > g ? 1u : 0u);
    const unsigned ngroups = gridDim.x < 8u ? gridDim.x : 8u;
    __builtin_amdgcn_fence(__ATOMIC_RELEASE, "agent");
    asm volatile("s_waitcnt vmcnt(0) lgkmcnt(0)" ::: "memory");
    unsigned v = __hip_atomic_fetch_add(&bar[g * 64], 1u, __ATOMIC_RELAXED, __HIP_MEMORY_SCOPE_AGENT) + 1u;
    if (v == gsize * epoch) __hip_atomic_fetch_add(&bar[512], 1u, __ATOMIC_RELAXED, __HIP_MEMORY_SCOPE_AGENT);
    while (__hip_atomic_load(&bar[512], __ATOMIC_RELAXED, __HIP_MEMORY_SCOPE_AGENT) < ngroups * epoch)
      __builtin_amdgcn_s_sleep(1);
    __builtin_amdgcn_fence(__ATOMIC_ACQUIRE, "agent");
    asm volatile("s_waitcnt vmcnt(0) lgkmcnt(0)" ::: "memory");
  }
  __syncthreads();
}

__global__ void __launch_bounds__(512) mega(P p) {
  extern __shared__ __attribute__((aligned(16))) char smem[];
  cg::grid_group grid = cg::this_grid();
  unsigned* bar = (unsigned*)(p.ws + W_BAR);
  unsigned epoch = 0;
#ifdef USE_CG_SYNC
#define GSYNC() grid.sync()
#else
#define GSYNC() grid_barrier(bar, epoch)
#endif
  const bf16_t* arena = (const bf16_t*)p.out;
  const bf16_t* hb = (const bf16_t*)(p.ws + W_HB);
  const bf16_t* act = (const bf16_t*)(p.ws + W_ACT);
  const bf16_t* z = (const bf16_t*)(p.ws + W_Z);
  const bf16_t* sg = (const bf16_t*)(p.ws + W_SG);

  phase0(p, smem);
  grid.sync();
  gemm_big<EPI_SWIGLU>(p, smem, hb, DM, MTOT, arena + A_WGU1, DM, 22, 0);
  GSYNC();
  gemm_phase<EPI_DOWN1>(p, smem, act, DFF, MTOT, arena + A_WD1, DFF, 8, 0);
  GSYNC();
  const bf16_t* oab = (const bf16_t*)(p.ws + W_OA);
  gemm_big<EPI_WIN>(p, smem, hb, DM, MH, arena + A_WIN, DM, 38, 0);
  GSYNC();
  for (int half = 0; half < 2; half++) {
    phase4(p, smem);
    GSYNC();
    for (int job = blockIdx.x; job < 192; job += gridDim.x) {
      {
      if (job < 128) rwkv_block(p, smem, job >> 2, job & 3);
      else delta_block(p, smem, (job - 128) >> 2, (job - 128) & 3);
      }
      __syncthreads();
    }
    GSYNC();
    gemm_phase<EPI_MERGE>(p, smem, sg, 192, MH, arena + A_GUP, 192, 8, half);
    GSYNC();
    gemm_phase<EPI_WOUT>(p, smem, oab, DM, MH, arena + A_WOUT, DM, 8, half);
    if (half == 0) gemm_big<EPI_WIN>(p, smem, hb + (size_t)MH * DM, DM, MH, arena + A_WIN, DM, 38, 1);
    GSYNC();
  }
  gemm_big<EPI_SWIGLU>(p, smem, hb, DM, MTOT, arena + A_WGU2, DM, 22, 1);
  GSYNC();
  gemm_phase<EPI_DOWN2>(p, smem, act, DFF, MTOT, arena + A_WD2, DFF, 8, 0);
  GSYNC();
  phase_final(p);
}

extern "C" void kernel_launch(void* const* d_in, const int* in_sizes, int n_in, void* d_out, int out_size, void* d_ws,
                              size_t ws_size, hipStream_t stream) {
  static int grid_blocks = 0;
  if (!grid_blocks) {
    int dev = 0, cus = 0, per_cu = 0;
    hipGetDevice(&dev);
    hipDeviceGetAttribute(&cus, hipDeviceAttributeMultiprocessorCount, dev);
    hipFuncSetAttribute((const void*)mega, hipFuncAttributeMaxDynamicSharedMemorySize, LDS_BYTES);
    hipOccupancyMaxActiveBlocksPerMultiprocessor(&per_cu, mega, 512, LDS_BYTES);
    if (per_cu < 1) per_cu = 1;
    if (per_cu > 1) per_cu = 1;
    grid_blocks = cus * per_cu;
  }
  P p{};
  const float* const* in = (const float* const*)d_in;
  p.x = in[0]; p.meta = in[1]; p.ffn1_norm = in[2]; p.ffn1_wgu = in[3]; p.ffn1_wd = in[4]; p.mix_norm = in[5];
  p.w_in = in[6]; p.conv_w = in[7]; p.log_rate = in[8]; p.dt_bias = in[9]; p.out_norm = in[10]; p.mu = in[11];
  p.w0 = in[12]; p.w_up = in[13]; p.a0 = in[14]; p.a_up = in[15]; p.g_up = in[16]; p.k_k = in[17]; p.k_a = in[18];
  p.r_k = in[19]; p.ln_g = in[20]; p.ln_b = in[21]; p.w_out = in[22]; p.ffn2_norm = in[23]; p.ffn2_wgu = in[24];
  p.ffn2_wd = in[25]; p.final_norm = in[26];
  p.out = (float*)d_out;
  p.ws = (char*)d_ws;
  (void)hipMemsetAsync((char*)d_ws + W_BAR, 0, 4096, stream);
  void* args[] = {&p};
  hipError_t e = hipLaunchCooperativeKernel((void*)mega, dim3(grid_blocks), dim3(512), args, LDS_BYTES, stream);
  if (e != hipSuccess) fprintf(stderr, "cooperative launch failed: %s (grid %d)\n", hipGetErrorString(e), grid_blocks);
}
```

```cpp
#include <hip/hip_runtime.h>
#include <hip/hip_cooperative_groups.h>
#include <stdint.h>
#include <stdio.h>
namespace cg = cooperative_groups;

typedef unsigned short bf16_t;
using bf16x8 = __attribute__((ext_vector_type(8))) short;
using f32x16 = __attribute__((ext_vector_type(16))) float;

#define DEV __device__ __forceinline__

constexpr int NB = 4, SEQ = 4096, NMETA = 16, TT = 4112, MTOT = NB * TT;
constexpr int DM = 1024, DFF = 2816, NIN = 9520, NINP = 9728;
constexpr int MH = 2 * TT;
constexpr int NCHUNK = 65;
constexpr int ZRW = 4112;
constexpr float EPS = 1e-6f;

constexpr size_t A_WGU1 = 0;
constexpr size_t A_WD1 = A_WGU1 + (size_t)2 * DFF * DM;
constexpr size_t A_WIN = A_WD1 + (size_t)DM * DFF;
constexpr size_t A_WOUT = A_WIN + (size_t)NINP * DM;
constexpr size_t A_WGU2 = A_WOUT + (size_t)DM * DM;
constexpr size_t A_WD2 = A_WGU2 + (size_t)2 * DFF * DM;
constexpr size_t A_GUP = A_WD2 + (size_t)DM * DFF;
constexpr size_t A_END = A_GUP + (size_t)DM * 192;
static_assert(A_END * 2 <= (size_t)NB * SEQ * DM * 4, "arena overflow");

constexpr size_t W_HB = 0;
constexpr size_t W_SS = W_HB + (size_t)MTOT * DM * 2;
constexpr size_t W_Z = W_SS + (size_t)4 * MTOT * 4;
constexpr size_t W_ACT = W_Z;
constexpr size_t W_H3 = W_Z + (size_t)MTOT * DFF * 2;
constexpr size_t W_BA = W_Z + (size_t)MH * NIN * 2;
constexpr size_t W_GB = W_BA + (size_t)MH * 16 * 4;
constexpr size_t W_BB = W_GB + (size_t)16 * NCHUNK * 64 * 4;
constexpr size_t W_TT = W_BB + (size_t)16 * NCHUNK * 64 * 4;
constexpr size_t W_OA = W_TT + (size_t)16 * NCHUNK * 4096 * 2;
constexpr size_t W_OST = W_OA + (size_t)MH * DM * 2;
constexpr size_t W_YB = W_OST + (size_t)MH * 32 * 4;
constexpr size_t W_YST = W_YB + (size_t)MH * DM * 2;
constexpr size_t W_BON = W_YST + (size_t)MH * 128 * 4;
constexpr size_t W_SG = W_BON + (size_t)MH * DM * 2;
constexpr size_t W_END = W_SG + (size_t)MH * 192 * 2;
constexpr size_t W_BAR = (W_END + 255) / 256 * 256;
constexpr size_t W_XWA = W_BAR + 4096;
static_assert(W_XWA + (size_t)MH * 128 * 2 <= (size_t)256 * 1024 * 1024, "ws overflow");
static_assert(W_H3 + (size_t)MTOT * DM * 4 <= (size_t)256 * 1024 * 1024, "ws overflow h3");

constexpr int LDS_BYTES = 147456;

struct P {
  const float *x, *meta, *ffn1_norm, *ffn1_wgu, *ffn1_wd, *mix_norm, *w_in, *conv_w, *log_rate, *dt_bias, *out_norm,
      *mu, *w0, *w_up, *a0, *a_up, *g_up, *k_k, *k_a, *r_k, *ln_g, *ln_b, *w_out, *ffn2_norm, *ffn2_wgu, *ffn2_wd,
      *final_norm;
  float* out;
  char* ws;
};

DEV bf16_t f2bf(float f) {
  uint32_t u = __float_as_uint(f);
  u += 0x7fffu + ((u >> 16) & 1u);
  return (bf16_t)(u >> 16);
}
DEV float bf2f(bf16_t b) { return __uint_as_float(((uint32_t)b) << 16); }
DEV uint32_t pack2(float a, float b) { return (uint32_t)f2bf(a) | ((uint32_t)f2bf(b) << 16); }
DEV float rcpf_(float x) { return __builtin_amdgcn_rcpf(x); }
DEV float sigmoidf_(float x) { return rcpf_(1.f + __expf(-x)); }
DEV float siluf_(float x) { return x * rcpf_(1.f + __expf(-x)); }
DEV float softplusf_(float x) { return x > 20.f ? x : log1pf(__expf(x)); }

template <int CTRL>
DEV float dpp_f(float v) {
  return __int_as_float(__builtin_amdgcn_update_dpp(0, __float_as_int(v), CTRL, 0xf, 0xf, true));
}
DEV float red16(float v) {
  v += dpp_f<0xB1>(v);
  v += dpp_f<0x4E>(v);
  v += dpp_f<0x141>(v);
  v += dpp_f<0x140>(v);
  return v;
}
DEV float red32(float v) { v = red16(v); v += __shfl_xor(v, 16); return v; }
DEV float red64(float v) { v = red32(v); v += __shfl_xor(v, 32); return v; }

DEV const float* h0row(const P& p, int m) {
  int b = m / TT, t = m - b * TT;
  return t < NMETA ? p.meta + (size_t)t * DM : p.x + ((size_t)b * SEQ + (t - NMETA)) * DM;
}

DEV f32x16 mm32(const bf16_t* A, int lda, const bf16_t* Bt, int ldb, int K, f32x16 acc, int lane) {
  const bf16_t* ap = A + (lane & 31) * lda + (lane >> 5) * 8;
  const bf16_t* bp = Bt + (lane & 31) * ldb + (lane >> 5) * 8;
  for (int k = 0; k < K; k += 16) {
    bf16x8 a = *(const bf16x8*)(ap + k);
    bf16x8 b = *(const bf16x8*)(bp + k);
    acc = __builtin_amdgcn_mfma_f32_32x32x16_bf16(a, b, acc, 0, 0, 0);
  }
  return acc;
}
DEV int otid() { int t = threadIdx.x; asm volatile("" : "+v"(t)); return t; }
#define WAVE_FENCE() asm volatile("s_waitcnt lgkmcnt(0)" ::: "memory")
DEV void lds_barrier() { asm volatile("s_waitcnt lgkmcnt(0)\n\ts_barrier" ::: "memory"); }
DEV int rowof(int r, int lane) { return 8 * (r >> 2) + 4 * (lane >> 5) + (r & 3); }

__device__ __forceinline__ void convert_matrix(const float* __restrict__ src, int Ksrc, int Nsrc, bf16_t* __restrict__ dst, int Rows,
                               int validRows, int Kdst, const float* __restrict__ scale, int mode, char* smem) {
  float* tile = (float*)smem;
  constexpr int NU = 4;
  const int tid = otid();
  const int kt_n = Kdst / 64;
  const int units = (Rows / 64) * kt_n;
  for (int u0 = blockIdx.x; u0 < units; u0 += NU * gridDim.x) {
    float v[NU][8];
#pragma unroll
    for (int w = 0; w < NU; w++) {
      const int u = u0 + w * gridDim.x;
      const int R0 = (u / kt_n) * 64, k0 = (u % kt_n) * 64;
#pragma unroll
      for (int q = 0; q < 8; q++) {
        const int e = tid + 512 * q;
        const int kk = e >> 6, rr = e & 63;
        const int R = R0 + rr, k = k0 + kk;
        float x = 0.f;
        if (u < units && R < validRows && k < Ksrc) {
          int col = R;
          if (mode == 1) {
            int j = R >> 7, r = R & 127;
            int wn = r >> 6, i = (r >> 5) & 1, pp = r & 31;
            col = (i ? DFF : 0) + j * 64 + wn * 32 + pp;
          }
          x = src[(size_t)k * Nsrc + col];
          if (scale) x *= scale[k];
        }
        v[w][q] = x;
      }
    }
#pragma unroll
    for (int w = 0; w < NU; w++)
#pragma unroll
      for (int q = 0; q < 8; q++) {
        const int e = tid + 512 * q;
        tile[w * 4160 + (e & 63) * 65 + (e >> 6)] = v[w][q];
      }
    __syncthreads();
#pragma unroll
    for (int w = 0; w < NU; w++) {
      const int u = u0 + w * gridDim.x;
      if (u < units) {
        const int R0 = (u / kt_n) * 64, k0 = (u % kt_n) * 64;
        const int rr = tid >> 3, kk0 = (tid & 7) * 8;
        const float* tp = tile + w * 4160 + rr * 65 + kk0;
        *(uint4*)(dst + (size_t)(R0 + rr) * Kdst + k0 + kk0) =
            make_uint4(pack2(tp[0], tp[1]), pack2(tp[2], tp[3]), pack2(tp[4], tp[5]), pack2(tp[6], tp[7]));
      }
    }
    __syncthreads();
  }
}

__device__ __forceinline__ void phase0(const P& p, char* smem) {
  bf16_t* arena = (bf16_t*)p.out;
  convert_matrix(p.ffn1_wgu, DM, 2 * DFF, arena + A_WGU1, 2 * DFF, 2 * DFF, DM, p.ffn1_norm, 1, smem);
  convert_matrix(p.ffn1_wd, DFF, DM, arena + A_WD1, DM, DM, DFF, nullptr, 0, smem);
  convert_matrix(p.w_in, DM, NIN, arena + A_WIN, NINP, NIN, DM, p.mix_norm, 0, smem);
  convert_matrix(p.w_out, DM, DM, arena + A_WOUT, DM, DM, DM, nullptr, 0, smem);
  convert_matrix(p.ffn2_wgu, DM, 2 * DFF, arena + A_WGU2, 2 * DFF, 2 * DFF, DM, p.ffn2_norm, 1, smem);
  convert_matrix(p.ffn2_wd, DFF, DM, arena + A_WD2, DM, DM, DFF, nullptr, 0, smem);
  convert_matrix(p.g_up, 160, DM, arena + A_GUP, DM, DM, 192, nullptr, 0, smem);
  bf16_t* hb = (bf16_t*)(p.ws + W_HB);
  float* ss = (float*)(p.ws + W_SS);
  const int tid_ = otid();
  const int lane = tid_ & 63, wv = tid_ >> 6;
  for (int m = blockIdx.x * 8 + wv; m < MTOT; m += gridDim.x * 8) {
    const float* src = h0row(p, m);
    float s = 0.f;
    float4 v4[4];
#pragma unroll
    for (int q = 0; q < 4; q++) v4[q] = *(const float4*)(src + q * 256 + lane * 4);
#pragma unroll
    for (int q = 0; q < 4; q++) {
      int c = q * 256 + lane * 4;
      float4 v = v4[q];
      uint32_t lo = pack2(v.x, v.y), hi = pack2(v.z, v.w);
      float a0 = bf2f(lo & 0xffff), a1 = bf2f(lo >> 16), a2 = bf2f(hi & 0xffff), a3 = bf2f(hi >> 16);
      s += a0 * a0 + a1 * a1 + a2 * a2 + a3 * a3;
      *(uint2*)(hb + (size_t)m * DM + c) = make_uint2(lo, hi);
    }
    s = red64(s);
    if (lane == 0) { ss[m] = s; ss[MTOT + m] = 0.f; ss[2 * MTOT + m] = 0.f; ss[3 * MTOT + m] = 0.f; }
  }
}

using u32x4 = __attribute__((ext_vector_type(4))) unsigned;
DEV void gld16(u32x4& r, const void* ptr) { asm volatile("global_load_dwordx4 %0, %1, off" : "=v"(r) : "v"(ptr) : "memory"); }
#define GLD_WAIT() asm volatile("s_waitcnt vmcnt(0)" ::: "memory")
DEV void gld16s(u32x4& r, const void* base, uint32_t off) {
  asm volatile("s_nop 4\n\tglobal_load_dwordx4 %0, %1, %2" : "=v"(r) : "v"(off), "s"(base) : "memory");
}
enum { EPI_SWIGLU = 0, EPI_DOWN1, EPI_WIN, EPI_MERGE, EPI_WOUT, EPI_DOWN2 };

struct EA {
  const P* p;
  int half;
};


template <int EPI, int SPLIT = 0>
__device__ __forceinline__ void gemm_phase(const P& p, char* smem_all, const bf16_t* __restrict__ X, int ldx, int Mrows,
                           const bf16_t* __restrict__ W, int K, int Ntiles, int half, bool dry_in = false) {
  constexpr int MT = SPLIT ? 128 : 256;
  constexpr int NTHR = SPLIT ? 256 : 512;
  constexpr int RSTEP = NTHR / 8;
  constexpr int NWL = 128 / RSTEP, NXL = MT / RSTEP;
  constexpr int STAGE = (128 + MT) * 72 * 2;
  const int tid = otid(), lane = tid & 63, wv = tid >> 6;
  const int grp = SPLIT ? (wv >> 2) : 0;
  const int wl = SPLIT ? (wv & 3) : wv;
  const int wn = wl & 1, wm = wl >> 1;
  char* smem = smem_all + grp * (2 * STAGE);
  const int Mtiles = (Mrows + MT - 1) / MT;
  const int total = Mtiles * Ntiles;
  const int KT = K / 64;
  const int gt = SPLIT ? (tid & 255) : tid;
  const int lrow = gt >> 3, lcol = (gt & 7) * 8;
  float* ss = (float*)(p.ws + W_SS);
  bf16_t* hb = (bf16_t*)(p.ws + W_HB);
  const int tstep = SPLIT ? 2 : 1;
  const int G8 = (gridDim.x & 7) == 0 ? (int)(gridDim.x >> 3) : 0;
  const int pb = (G8 && !SPLIT) ? (int)((blockIdx.x & 7) * G8 + (blockIdx.x >> 3)) : (int)blockIdx.x;
  const int mfull = (Mtiles >> 2) << 2, nfull = mfull * Ntiles, mrem = Mtiles - mfull;
  for (int tbase = pb * tstep; tbase < total; tbase += gridDim.x * tstep) {
    int tile = tbase + grp;
    const bool dry = dry_in || (tile >= total);
    tile = tile < total ? tile : total - 1;
    int mt, nt;
    if (SPLIT) { mt = tile / Ntiles; nt = tile - mt * Ntiles; }
    else if (tile < nfull) {
      const int rg = tile / (4 * Ntiles), rem = tile - rg * 4 * Ntiles;
      nt = rem >> 2;
      mt = rg * 4 + (rem & 3);
    } else {
      const int rem = tile - nfull;
      nt = rem / mrem;
      mt = mfull + (rem - nt * mrem);
    }
    const int m0 = mt * MT, n0 = nt * 128;
    u32x4 w0r[NWL], x0r[NXL], w1r[NWL], x1r[NXL];
    f32x16 acc[2][2];
#pragma unroll
    for (int i = 0; i < 2; i++)
#pragma unroll
      for (int j = 0; j < 2; j++)
#pragma unroll
        for (int r = 0; r < 16; r++) acc[i][j][r] = 0.f;

    auto gload = [&](u32x4 (&wr)[NWL], u32x4 (&xr)[NXL], int kt) {
#pragma unroll
      for (int q = 0; q < NWL; q++) {
        int row = lrow + RSTEP * q;
        gld16(wr[q], W + (size_t)(n0 + row) * K + kt * 64 + lcol);
      }
#pragma unroll
      for (int q = 0; q < NXL; q++) {
        int row = m0 + lrow + RSTEP * q;
        row = row < Mrows ? row : Mrows - 1;
        gld16(xr[q], X + (size_t)row * ldx + kt * 64 + lcol);
      }
    };
    auto sstore = [&](u32x4 (&wr)[NWL], u32x4 (&xr)[NXL], int st) {
      bf16_t* Ws = (bf16_t*)(smem + st * STAGE);
      bf16_t* Xs = Ws + 128 * 72;
#pragma unroll
      for (int q = 0; q < NWL; q++) *(u32x4*)(Ws + (lrow + RSTEP * q) * 72 + lcol) = wr[q];
#pragma unroll
      for (int q = 0; q < NXL; q++) *(u32x4*)(Xs + (lrow + RSTEP * q) * 72 + lcol) = xr[q];
    };
    const bool wact = __builtin_amdgcn_readfirstlane(m0 + wm * 64) < Mrows;
    auto compute = [&](int st) {
      if (!wact) return;
      const bf16_t* Ws = (const bf16_t*)(smem + st * STAGE);
      const bf16_t* Xs = Ws + 128 * 72;
      const bf16_t* ap = Ws + (wn * 64 + (lane & 31)) * 72 + (lane >> 5) * 8;
      const bf16_t* bp = Xs + (wm * 64 + (lane & 31)) * 72 + (lane >> 5) * 8;
#pragma unroll
      for (int kk = 0; kk < 4; kk++) {
        bf16x8 a0 = *(const bf16x8*)(ap + kk * 16);
        bf16x8 a1 = *(const bf16x8*)(ap + 32 * 72 + kk * 16);
        bf16x8 b0 = *(const bf16x8*)(bp + kk * 16);
        bf16x8 b1 = *(const bf16x8*)(bp + 32 * 72 + kk * 16);
        acc[0][0] = __builtin_amdgcn_mfma_f32_32x32x16_bf16(a0, b0, acc[0][0], 0, 0, 0);
        acc[0][1] = __builtin_amdgcn_mfma_f32_32x32x16_bf16(a0, b1, acc[0][1], 0, 0, 0);
        acc[1][0] = __builtin_amdgcn_mfma_f32_32x32x16_bf16(a1, b0, acc[1][0], 0, 0, 0);
        acc[1][1] = __builtin_amdgcn_mfma_f32_32x32x16_bf16(a1, b1, acc[1][1], 0, 0, 0);
      }
    };
    auto kstep = [&](u32x4 (&wr)[NWL], u32x4 (&xr)[NXL], int kt) {
      compute(kt & 1);
      if (kt + 1 < KT) {
        if (kt + 2 < KT) asm volatile("s_waitcnt vmcnt(%0)" ::"n"(NWL + NXL) : "memory");
        else GLD_WAIT();
        sstore(wr, xr, (kt + 1) & 1);
        if (kt + 3 < KT) gload(wr, xr, kt + 3);
      }
      __syncthreads();
    };
    gload(w0r, x0r, 0);
    GLD_WAIT();
    sstore(w0r, x0r, 0);
    if (KT > 1) gload(w1r, x1r, 1);
    if (KT > 2) gload(w0r, x0r, 2);
    __syncthreads();
    for (int kt = 0; kt < KT; kt += 2) {
      kstep(w1r, x1r, kt);
      if (kt + 1 < KT) kstep(w0r, x0r, kt + 1);
    }
    const int hh = lane >> 5;
    float* cst_s = (float*)(smem_all + 2 * STAGE);
    if (EPI == EPI_MERGE) {
      if (tid < 384) {
        const int a = tid >> 7, cl = tid & 127, c = n0 + cl;
        cst_s[tid] = a == 0 ? p.out_norm[c & 127] : (a == 1 ? p.ln_g[c] : p.ln_b[c]);
      }
      __syncthreads();
    }
#pragma unroll
    for (int j = 0; j < 2; j++) {
      if (__builtin_amdgcn_readfirstlane(m0 + wm * 64 + j * 32) >= Mrows) continue;
      const int m = m0 + wm * 64 + j * 32 + (lane & 31);
      const bool mv = (m < Mrows) && !dry;
      const int mc = mv ? m : Mrows - 1;
      if (EPI == EPI_SWIGLU) {
        const float rs = rsqrtf(ss[(half ? 2 : 0) * MTOT + mc] * (1.f / DM) + EPS);
        bf16_t* act = (bf16_t*)(p.ws + W_ACT);
#pragma unroll
        for (int g = 0; g < 4; g++) {
          float o[4];
#pragma unroll
          for (int e = 0; e < 4; e++) {
            float gt = acc[0][j][4 * g + e] * rs, up = acc[1][j][4 * g + e] * rs;
            o[e] = siluf_(gt) * up;
          }
          int col = nt * 64 + wn * 32 + 8 * g + 4 * hh;
          if (mv) *(uint2*)(act + (size_t)m * DFF + col) = make_uint2(pack2(o[0], o[1]), pack2(o[2], o[3]));
        }
      } else if (EPI == EPI_DOWN1 || EPI == EPI_WOUT || EPI == EPI_DOWN2) {
        const int mg = (EPI == EPI_WOUT) ? half * MH + mc : mc;
        float ssq = 0.f;
        const float* h0 = (EPI == EPI_DOWN1) ? h0row(p, mg) : nullptr;
        float* h3 = (float*)(p.ws + W_H3);
        float4 rf[2][4];
        uint2 rb[2][4];
#pragma unroll
        for (int i = 0; i < 2; i++)
#pragma unroll
          for (int g = 0; g < 4; g++) {
            const int n = n0 + wn * 64 + i * 32 + 8 * g + 4 * hh;
            if (EPI == EPI_DOWN1) rf[i][g] = *(const float4*)(h0 + n);
            else rb[i][g] = *(const uint2*)(hb + (size_t)mg * DM + n);
          }
#pragma unroll
        for (int i = 0; i < 2; i++)
#pragma unroll
          for (int g = 0; g < 4; g++) {
            const int n = n0 + wn * 64 + i * 32 + 8 * g + 4 * hh;
            float o[4];
            if (EPI == EPI_DOWN1) {
              const float4 r = rf[i][g];
              o[0] = r.x + 0.5f * acc[i][j][4 * g + 0];
              o[1] = r.y + 0.5f * acc[i][j][4 * g + 1];
              o[2] = r.z + 0.5f * acc[i][j][4 * g + 2];
              o[3] = r.w + 0.5f * acc[i][j][4 * g + 3];
            } else {
              const uint2 r = rb[i][g];
              const float sc = (EPI == EPI_WOUT) ? 1.f : 0.5f;
              o[0] = bf2f(r.x & 0xffff) + sc * acc[i][j][4 * g + 0];
              o[1] = bf2f(r.x >> 16) + sc * acc[i][j][4 * g + 1];
              o[2] = bf2f(r.y & 0xffff) + sc * acc[i][j][4 * g + 2];
              o[3] = bf2f(r.y >> 16) + sc * acc[i][j][4 * g + 3];
            }
            if (EPI == EPI_DOWN2) {
              ssq += o[0] * o[0] + o[1] * o[1] + o[2] * o[2] + o[3] * o[3];
              if (mv) *(float4*)(h3 + (size_t)mg * DM + n) = make_float4(o[0], o[1], o[2], o[3]);
            } else {
              uint32_t lo = pack2(o[0], o[1]), hi = pack2(o[2], o[3]);
              float q0 = bf2f(lo & 0xffff), q1 = bf2f(lo >> 16), q2 = bf2f(hi & 0xffff), q3 = bf2f(hi >> 16);
              ssq += q0 * q0 + q1 * q1 + q2 * q2 + q3 * q3;
              if (mv) *(uint2*)(hb + (size_t)mg * DM + n) = make_uint2(lo, hi);
            }
          }
        ssq += __shfl_xor(ssq, 32);
        const int which = (EPI == EPI_DOWN1) ? 1 : (EPI == EPI_WOUT ? 2 : 3);
        if (mv && hh == 0) atomicAdd(&ss[which * MTOT + mg], ssq);
      } else if (EPI == EPI_WIN) {
        const int mg = half * MH + mc;
        const float rs = rsqrtf(ss[1 * MTOT + mg] * (1.f / DM) + EPS);
        bf16_t* z = (bf16_t*)(p.ws + W_Z);
        float* ba = (float*)(p.ws + W_BA);
#pragma unroll
        for (int i = 0; i < 2; i++)
#pragma unroll
          for (int g = 0; g < 4; g++) {
            const int n = n0 + wn * 64 + i * 32 + 8 * g + 4 * hh;
            float o0 = acc[i][j][4 * g + 0] * rs, o1 = acc[i][j][4 * g + 1] * rs, o2 = acc[i][j][4 * g + 2] * rs,
                  o3 = acc[i][j][4 * g + 3] * rs;
            if (mv && n < NIN) {
              *(uint2*)(z + (size_t)m * NIN + n) = make_uint2(pack2(o0, o1), pack2(o2, o3));
              if (n >= 4096 && n < 4112) *(float4*)(ba + (size_t)m * 16 + (n - 4096)) = make_float4(o0, o1, o2, o3);
            }
          }
      } else if (EPI == EPI_MERGE) {
        bf16_t* z = (bf16_t*)(p.ws + W_Z);
        const bf16_t* oa = (const bf16_t*)(p.ws + W_OA);
        const float* ost = (const float*)(p.ws + W_OST);
        const bf16_t* yb = (const bf16_t*)(p.ws + W_YB);
        const float* yst = (const float*)(p.ws + W_YST);
        const bf16_t* bon = (const bf16_t*)(p.ws + W_BON);
        const int cw0 = n0 + wn * 64;
        const float4 os = *(const float4*)(ost + ((size_t)mc * 8 + (cw0 >> 7)) * 4);
        const float* ys = yst + ((size_t)mc * 16 + (cw0 >> 6)) * 8;
        const float4 y0 = *(const float4*)ys, y1 = *(const float4*)(ys + 4);
        const float rstd_a = rsqrtf((os.x + os.y + os.z + os.w) * (1.f / 128.f) + EPS);
        const float sy = y0.x + y0.z + y1.x + y1.z, sy2 = y0.y + y0.w + y1.y + y1.w;
        const float mean = sy * (1.f / 64.f);
        const float var = fmaxf(sy2 * (1.f / 64.f) - mean * mean, 0.f);
        const float rstd_b = rsqrtf(var + 64e-5f);
#pragma unroll
        for (int i = 0; i < 2; i++) {
          uint2 L[4][6];
#pragma unroll
          for (int g = 0; g < 4; g++) {
            const int c = cw0 + i * 32 + 8 * g + 4 * hh;
            L[g][0] = *(const uint2*)(oa + (size_t)mc * DM + c);
            L[g][1] = *(const uint2*)(yb + (size_t)mc * DM + c);
            L[g][2] = *(const uint2*)(bon + (size_t)mc * DM + c);
            L[g][3] = *(const uint2*)(z + (size_t)mc * NIN + 3072 + c);
            L[g][4] = *(const uint2*)(z + (size_t)mc * NIN + 7472 + c);
            L[g][5] = *(const uint2*)(z + (size_t)mc * NIN + 8496 + c);
          }
#pragma unroll
          for (int g = 0; g < 4; g++) {
            const int c = cw0 + i * 32 + 8 * g + 4 * hh;
            const int cl = c - n0;
            const float4 on4 = *(const float4*)(cst_s + cl), lg4 = *(const float4*)(cst_s + 128 + cl),
                         lb4 = *(const float4*)(cst_s + 256 + cl);
            const float onv[4] = {on4.x, on4.y, on4.z, on4.w}, lgv[4] = {lg4.x, lg4.y, lg4.z, lg4.w},
                        lbv[4] = {lb4.x, lb4.y, lb4.z, lb4.w};
            float o[4];
#pragma unroll
            for (int e = 0; e < 4; e++) {
              auto sel = [&](uint2 v) { uint32_t w = (e < 2) ? v.x : v.y; return bf2f((e & 1) ? (w >> 16) : (w & 0xffff)); };
              float oav = sel(L[g][0]) * rstd_a * onv[e] * siluf_(sel(L[g][3]));
              float yn = (sel(L[g][1]) - mean) * rstd_b * lgv[e] + lbv[e] + sel(L[g][2]);
              float obv = yn * acc[i][j][4 * g + e];
              o[e] = sigmoidf_(sel(L[g][4])) * oav + sigmoidf_(sel(L[g][5])) * obv;
            }
            if (mv) *(uint2*)((bf16_t*)oa + (size_t)m * DM + c) = make_uint2(pack2(o[0], o[1]), pack2(o[2], o[3]));
          }
        }
      }
    }
    if (EPI == EPI_MERGE) __syncthreads();
  }
}


template <int EPI>
__device__ __forceinline__ void gemm_big(const P& p, char* smem, const bf16_t* __restrict__ X, int ldx, int Mrows,
                                         const bf16_t* __restrict__ W, int K, int Ntiles, int half) {
  constexpr int STAGE = 512 * 72 * 2;
  const int tid = otid(), lane = tid & 63, wv = tid >> 6;
  const int wn = wv & 1, wm = wv >> 1;
  const int Mtiles = (Mrows + 255) / 256;
  const int total = Mtiles * Ntiles;
  const int KT = K / 64;
  const int lrow = tid >> 3, lcol = (tid & 7) * 8;
  float* ss = (float*)(p.ws + W_SS);
  const int G8 = (gridDim.x & 7) == 0 ? (int)(gridDim.x >> 3) : 0;
  const int pb = G8 ? (int)((blockIdx.x & 7) * G8 + (blockIdx.x >> 3)) : (int)blockIdx.x;
  const int mfull = (Mtiles >> 2) << 2, nfull = mfull * Ntiles, mrem = Mtiles - mfull;
  for (int tile = pb; tile < total; tile += gridDim.x) {
    int mt, nt;
    if (tile < nfull) {
      const int rg = tile / (4 * Ntiles), rem = tile - rg * 4 * Ntiles;
      nt = rem >> 2;
      mt = rg * 4 + (rem & 3);
    } else {
      const int rem = tile - nfull;
      nt = rem / mrem;
      mt = mfull + (rem - nt * mrem);
    }
    const int m0 = mt * 256, n0 = nt * 256;
    u32x4 wr[4], xr[4];
    f32x16 acc[4][2];
#pragma unroll
    for (int i = 0; i < 4; i++)
#pragma unroll
      for (int j = 0; j < 2; j++)
#pragma unroll
        for (int r = 0; r < 16; r++) acc[i][j][r] = 0.f;
    uint32_t woff[4], xoff[4];
#pragma unroll
    for (int q = 0; q < 4; q++) {
      woff[q] = (uint32_t)(((size_t)(n0 + lrow + 64 * q) * K + lcol) * 2);
      int row = m0 + lrow + 64 * q;
      row = row < Mrows ? row : Mrows - 1;
      xoff[q] = (uint32_t)(((size_t)row * ldx + lcol) * 2);
    }
    auto gload = [&](int kt) {
      const bf16_t* wb = W + kt * 64;
      const bf16_t* xb = X + kt * 64;
#pragma unroll
      for (int q = 0; q < 4; q++) gld16s(wr[q], wb, woff[q]);
#pragma unroll
      for (int q = 0; q < 4; q++) gld16s(xr[q], xb, xoff[q]);
    };
    auto sstore = [&](int st) {
      bf16_t* Ws = (bf16_t*)(smem + st * STAGE);
      bf16_t* Xs = Ws + 256 * 72;
#pragma unroll
      for (int q = 0; q < 4; q++) *(u32x4*)(Ws + (lrow + 64 * q) * 72 + lcol) = wr[q];
#pragma unroll
      for (int q = 0; q < 4; q++) *(u32x4*)(Xs + (lrow + 64 * q) * 72 + lcol) = xr[q];
    };
    const bool wact = __builtin_amdgcn_readfirstlane(m0 + wm * 64) < Mrows;
    gload(0);
    GLD_WAIT();
    sstore(0);
    if (KT > 1) gload(1);
    __syncthreads();
    for (int kt = 0; kt < KT; kt++) {
      if (wact) {
        const bf16_t* Ws = (const bf16_t*)(smem + (kt & 1) * STAGE);
        const bf16_t* Xs = Ws + 256 * 72;
        const bf16_t* ap = Ws + (wn * 128 + (lane & 31)) * 72 + (lane >> 5) * 8;
        const bf16_t* bp = Xs + (wm * 64 + (lane & 31)) * 72 + (lane >> 5) * 8;
        bf16x8 b0 = *(const bf16x8*)(bp), b1 = *(const bf16x8*)(bp + 32 * 72);
        bf16x8 a0 = *(const bf16x8*)(ap), a1 = *(const bf16x8*)(ap + 32 * 72), a2 = *(const bf16x8*)(ap + 64 * 72),
               a3 = *(const bf16x8*)(ap + 96 * 72);
#pragma unroll
        for (int kk = 0; kk < 4; kk++) {
          bf16x8 nb0, nb1, na0, na1, na2, na3;
          if (kk < 3) {
            nb0 = *(const bf16x8*)(bp + (kk + 1) * 16); nb1 = *(const bf16x8*)(bp + 32 * 72 + (kk + 1) * 16);
            na0 = *(const bf16x8*)(ap + (kk + 1) * 16); na1 = *(const bf16x8*)(ap + 32 * 72 + (kk + 1) * 16);
            na2 = *(const bf16x8*)(ap + 64 * 72 + (kk + 1) * 16); na3 = *(const bf16x8*)(ap + 96 * 72 + (kk + 1) * 16);
          }
          acc[0][0] = __builtin_amdgcn_mfma_f32_32x32x16_bf16(a0, b0, acc[0][0], 0, 0, 0);
          acc[0][1] = __builtin_amdgcn_mfma_f32_32x32x16_bf16(a0, b1, acc[0][1], 0, 0, 0);
          acc[1][0] = __builtin_amdgcn_mfma_f32_32x32x16_bf16(a1, b0, acc[1][0], 0, 0, 0);
          acc[1][1] = __builtin_amdgcn_mfma_f32_32x32x16_bf16(a1, b1, acc[1][1], 0, 0, 0);
          acc[2][0] = __builtin_amdgcn_mfma_f32_32x32x16_bf16(a2, b0, acc[2][0], 0, 0, 0);
          acc[2][1] = __builtin_amdgcn_mfma_f32_32x32x16_bf16(a2, b1, acc[2][1], 0, 0, 0);
          acc[3][0] = __builtin_amdgcn_mfma_f32_32x32x16_bf16(a3, b0, acc[3][0], 0, 0, 0);
          acc[3][1] = __builtin_amdgcn_mfma_f32_32x32x16_bf16(a3, b1, acc[3][1], 0, 0, 0);
          if (kk < 3) { b0 = nb0; b1 = nb1; a0 = na0; a1 = na1; a2 = na2; a3 = na3; }
        }
      }
      if (kt + 1 < KT) {
        GLD_WAIT();
        sstore((kt + 1) & 1);
        if (kt + 2 < KT) gload(kt + 2);
      }
      __syncthreads();
    }
    const int hh = lane >> 5;
#pragma unroll
    for (int j = 0; j < 2; j++) {
      if (__builtin_amdgcn_readfirstlane(m0 + wm * 64 + j * 32) >= Mrows) continue;
      const int m = m0 + wm * 64 + j * 32 + (lane & 31);
      const bool mv = m < Mrows;
      const int mc = mv ? m : Mrows - 1;
      if (EPI == EPI_SWIGLU) {
        const float rs = rsqrtf(ss[(half ? 2 : 0) * MTOT + mc] * (1.f / DM) + EPS);
        bf16_t* act = (bf16_t*)(p.ws + W_ACT);
#pragma unroll
        for (int pr = 0; pr < 2; pr++)
#pragma unroll
          for (int g = 0; g < 4; g++) {
            float o[4];
#pragma unroll
            for (int e = 0; e < 4; e++) {
              float gt = acc[2 * pr][j][4 * g + e] * rs, up = acc[2 * pr + 1][j][4 * g + e] * rs;
              o[e] = siluf_(gt) * up;
            }
            int col = (2 * nt + wn) * 64 + pr * 32 + 8 * g + 4 * hh;
            if (mv) *(uint2*)(act + (size_t)m * DFF + col) = make_uint2(pack2(o[0], o[1]), pack2(o[2], o[3]));
          }
      } else {
        const int mg = half * MH + mc;
        const float rs = rsqrtf(ss[1 * MTOT + mg] * (1.f / DM) + EPS);
        bf16_t* z = (bf16_t*)(p.ws + W_Z);
        float* ba = (float*)(p.ws + W_BA);
#pragma unroll
        for (int i = 0; i < 4; i++)
#pragma unroll
          for (int g = 0; g < 4; g++) {
            const int n = n0 + wn * 128 + i * 32 + 8 * g + 4 * hh;
            float o0 = acc[i][j][4 * g + 0] * rs, o1 = acc[i][j][4 * g + 1] * rs, o2 = acc[i][j][4 * g + 2] * rs,
                  o3 = acc[i][j][4 * g + 3] * rs;
            if (mv && n < NIN) {
              *(uint2*)(z + (size_t)m * NIN + n) = make_uint2(pack2(o0, o1), pack2(o2, o3));
              if (n >= 4096 && n < 4112) *(float4*)(ba + (size_t)m * 16 + (n - 4096)) = make_float4(o0, o1, o2, o3);
            }
          }
      }
    }
  }
}

DEV void conv8(const bf16_t* __restrict__ Zb, int t, int zc, const float* __restrict__ cw, float (&o)[8]) {
#pragma unroll
  for (int e = 0; e < 8; e++) o[e] = 0.f;
#pragma unroll
  for (int j = 0; j < 4; j++) {
    int tt = t - 3 + j;
    if (tt >= 0) {
      uint4 raw = *(const uint4*)(Zb + (size_t)tt * NIN + zc);
      float4 w0 = *(const float4*)(cw + j * 3072 + zc), w1 = *(const float4*)(cw + j * 3072 + zc + 4);
      o[0] += bf2f(raw.x & 0xffff) * w0.x; o[1] += bf2f(raw.x >> 16) * w0.y;
      o[2] += bf2f(raw.y & 0xffff) * w0.z; o[3] += bf2f(raw.y >> 16) * w0.w;
      o[4] += bf2f(raw.z & 0xffff) * w1.x; o[5] += bf2f(raw.z >> 16) * w1.y;
      o[6] += bf2f(raw.w & 0xffff) * w1.z; o[7] += bf2f(raw.w >> 16) * w1.w;
    }
  }
#pragma unroll
  for (int e = 0; e < 8; e++) o[e] = siluf_(o[e]);
}

__device__ __forceinline__ void phase4(const P& p, char* smem) {
  const int tid = otid(), lane = tid & 63, wv = tid >> 6;
  char* gs = smem + wv * 18432;
  float* g_s = (float*)gs;
  float* be_s = g_s + 64;
  bf16_t* kn = (bf16_t*)(gs + 512);
  float* Mf = (float*)(gs + 512);
  const bf16_t* z = (const bf16_t*)(p.ws + W_Z);
  const float* ba = (const float*)(p.ws + W_BA);
  float* GB = (float*)(p.ws + W_GB);
  float* BB = (float*)(p.ws + W_BB);
  bf16_t* TTb = (bf16_t*)(p.ws + W_TT);
  for (int task = blockIdx.x * 8 + wv; task < 16 * NCHUNK; task += gridDim.x * 8) {
    const int unit = task / NCHUNK, n = task - unit * NCHUNK;
    const int bl = unit >> 3, h = unit & 7;
    const int tbase = n * 64 - 48;
    const bf16_t* Zb = z + (size_t)bl * TT * NIN;
    {
      int t = tbase + lane;
      float g = 0.f, be = 0.f;
      if (t >= 0) {
        size_t mrow = (size_t)bl * TT + t;
        float bp = ba[mrow * 16 + h], al = ba[mrow * 16 + 8 + h];
        g = -__expf(p.log_rate[h]) * softplusf_(al + p.dt_bias[h]);
        be = sigmoidf_(bp);
      }
#pragma unroll
      for (int d = 1; d < 64; d <<= 1) {
        float tq = __shfl_up(g, d);
        if (lane >= d) g += tq;
      }
      g_s[lane] = g;
      be_s[lane] = be;
      GB[(size_t)task * 64 + lane] = g;
      BB[(size_t)task * 64 + lane] = be;
    }
#pragma unroll 4
    for (int q = 0; q < 16; q++) {
      int id = lane + 64 * q;
      int row = id >> 4, cgp = id & 15;
      float o[8];
      conv8(Zb, tbase + row, 1024 + h * 128 + cgp * 8, p.conv_w, o);
      float sq = 0.f;
#pragma unroll
      for (int e = 0; e < 8; e++) sq += o[e] * o[e];
      sq = red16(sq);
      float sc = rsqrtf(sq + 1e-6f);
      *(uint4*)(kn + row * 136 + cgp * 8) =
          make_uint4(pack2(o[0] * sc, o[1] * sc), pack2(o[2] * sc, o[3] * sc), pack2(o[4] * sc, o[5] * sc),
                     pack2(o[6] * sc, o[7] * sc));
    }
    WAVE_FENCE();
    f32x16 kk[4];
#pragma unroll
    for (int tq = 0; tq < 4; tq++) {
#pragma unroll
      for (int r = 0; r < 16; r++) kk[tq][r] = 0.f;
      kk[tq] = mm32(kn + (tq >> 1) * 32 * 136, 136, kn + (tq & 1) * 32 * 136, 136, 128, kk[tq], lane);
    }
    WAVE_FENCE();
#pragma unroll
    for (int tq = 0; tq < 4; tq++) {
#pragma unroll
      for (int r = 0; r < 16; r++) {
        int c = (tq >> 1) * 32 + rowof(r, lane), sx = (tq & 1) * 32 + (lane & 31);
        float v = (c > sx) ? be_s[c] * kk[tq][r] * __expf(g_s[c] - g_s[sx]) : 0.f;
        Mf[c * 68 + sx] = v;
      }
    }
    WAVE_FENCE();
    bf16_t* Tg = TTb + (size_t)task * 4096;
    {
      float x[64];
#pragma unroll
      for (int c = 0; c < 64; c++) x[c] = 0.f;
#pragma unroll
      for (int c = 0; c < 64; c++) {
        float a0 = (lane == c) ? 1.f : 0.f, a1 = 0.f, a2 = 0.f, a3 = 0.f;
#pragma unroll
        for (int s4 = 0; s4 < (c + 3) / 4; s4++) {
          const float4 mv = *(const float4*)(Mf + c * 68 + s4 * 4);
          a0 -= mv.x * x[s4 * 4 + 0];
          a1 -= mv.y * x[s4 * 4 + 1];
          a2 -= mv.z * x[s4 * 4 + 2];
          a3 -= mv.w * x[s4 * 4 + 3];
        }
        x[c] = (a0 + a1) + (a2 + a3);
        Tg[c * 64 + lane] = f2bf(x[c]);
      }
    }
    WAVE_FENCE();
  }
  bf16_t* sg = (bf16_t*)(p.ws + W_SG);
  for (int idx = blockIdx.x * 512 + tid; idx < MH * 24; idx += gridDim.x * 512) {
    const int m = idx / 24, jg = idx - m * 24;
    uint4 outv = make_uint4(0, 0, 0, 0);
    if (jg < 20) {
      const int t = m % TT;
      const bf16_t* src = z + (size_t)m * NIN + ZRW + 3200 + jg * 8;
      const uint4 cu = *(const uint4*)src;
      uint4 pr = make_uint4(0, 0, 0, 0);
      if (t > 0) pr = *(const uint4*)(src - NIN);
      const float4 m0 = *(const float4*)(p.mu + 3200 + jg * 8), m1 = *(const float4*)(p.mu + 3200 + jg * 8 + 4);
      const float mm[8] = {m0.x, m0.y, m0.z, m0.w, m1.x, m1.y, m1.z, m1.w};
      const uint32_t cw[4] = {cu.x, cu.y, cu.z, cu.w}, pw[4] = {pr.x, pr.y, pr.z, pr.w};
      float v[8];
#pragma unroll
      for (int e = 0; e < 8; e++) {
        float c = bf2f((e & 1) ? (cw[e >> 1] >> 16) : (cw[e >> 1] & 0xffff));
        float q = bf2f((e & 1) ? (pw[e >> 1] >> 16) : (pw[e >> 1] & 0xffff));
        v[e] = sigmoidf_(c + (q - c) * mm[e]);
      }
      outv = make_uint4(pack2(v[0], v[1]), pack2(v[2], v[3]), pack2(v[4], v[5]), pack2(v[6], v[7]));
    }
    *(uint4*)(sg + (size_t)m * 192 + jg * 8) = outv;
  }
  bf16_t* xwa = (bf16_t*)(p.ws + W_XWA);
  for (int idx = blockIdx.x * 512 + tid; idx < MH * 16; idx += gridDim.x * 512) {
    const int m = idx >> 4, jg = idx & 15;
    const int t = m % TT;
    const bf16_t* src = z + (size_t)m * NIN + ZRW + 3072 + jg * 8;
    const uint4 cu = *(const uint4*)src;
    uint4 pr = make_uint4(0, 0, 0, 0);
    if (t > 0) pr = *(const uint4*)(src - NIN);
    const float4 m0 = *(const float4*)(p.mu + 3072 + jg * 8), m1 = *(const float4*)(p.mu + 3072 + jg * 8 + 4);
    const float mm[8] = {m0.x, m0.y, m0.z, m0.w, m1.x, m1.y, m1.z, m1.w};
    const uint32_t cw[4] = {cu.x, cu.y, cu.z, cu.w}, pw[4] = {pr.x, pr.y, pr.z, pr.w};
    float v[8];
#pragma unroll
    for (int e = 0; e < 8; e++) {
      float c = bf2f((e & 1) ? (cw[e >> 1] >> 16) : (cw[e >> 1] & 0xffff));
      float q = bf2f((e & 1) ? (pw[e >> 1] >> 16) : (pw[e >> 1] & 0xffff));
      float x = c + (q - c) * mm[e];
      if (jg < 8) { float ex = __expf(2.f * x); x = 1.f - 2.f * rcpf_(ex + 1.f); }
      v[e] = x;
    }
    *(uint4*)(xwa + (size_t)m * 128 + jg * 8) = make_uint4(pack2(v[0], v[1]), pack2(v[2], v[3]), pack2(v[4], v[5]), pack2(v[6], v[7]));
  }
}

constexpr int RLD = 68;
constexpr int RW_NC = (TT + 31) / 32;
constexpr int RW_BUF = (5 * 32 * RLD + 32 * 16 + 32) * 4;
DEV int rw_rel(int ch, int h, int rq) {
  return ch < 8 ? h * 64 + ch * 8
       : ch < 16 ? 1024 + h * 64 + (ch - 8) * 8
       : ch < 24 ? 3072 + (ch - 16) * 8
       : ch < 32 ? 3136 + (ch - 24) * 8
                 : 2048 + h * 64 + rq * 16 + (ch - 32) * 8;
}
DEV float wave_sum_bcast(float v) {
  v = red16(v);
  float r0 = __int_as_float(__builtin_amdgcn_readlane(__float_as_int(v), 0));
  float r1 = __int_as_float(__builtin_amdgcn_readlane(__float_as_int(v), 16));
  float r2 = __int_as_float(__builtin_amdgcn_readlane(__float_as_int(v), 32));
  float r3 = __int_as_float(__builtin_amdgcn_readlane(__float_as_int(v), 48));
  return (r0 + r1) + (r2 + r3);
}
__device__ __forceinline__ void rwkv_block(const P& p, char* smem, int unit, int rq) {
  const int tid = otid(), lane = tid & 63;
  const int wv = __builtin_amdgcn_readfirstlane(tid >> 6);
  const int bl = unit >> 4, h = unit & 15;
  bf16_t* wupT = (bf16_t*)smem;
  bf16_t* aupT = wupT + 64 * 72;
  bf16_t* Xw = aupT + 64 * 72;
  bf16_t* Xa = Xw + 32 * 72;
  bf16_t* raw_all = Xa + 32 * 72;
  float* mu_s = (float*)(raw_all + 4 * 9 * 272);
  float* y_all = mu_s + 272;
  char* obuf = (char*)(y_all + 2 * 512);
  for (int e = tid; e < 4096; e += 512) {
    int j = e >> 6, c = e & 63;
    wupT[c * 72 + j] = f2bf(p.w_up[(size_t)j * DM + h * 64 + c]);
    aupT[c * 72 + j] = f2bf(p.a_up[(size_t)j * DM + h * 64 + c]);
  }
  for (int e = tid; e < 2 * 32 * 72; e += 512) Xw[e] = 0;
  if (tid < 272) mu_s[tid] = p.mu[rw_rel(tid >> 3, h, rq) + (tid & 7)];
  const bf16_t* Zb = (const bf16_t*)(p.ws + W_Z) + (size_t)bl * TT * NIN + ZRW;
  bf16_t* YB = (bf16_t*)(p.ws + W_YB);
  bf16_t* BON = (bf16_t*)(p.ws + W_BON);
  float* YST = (float*)(p.ws + W_YST);
  __syncthreads();
  if (wv >= 4) {
    const int pw = wv - 4;
    bf16_t* raw_s = raw_all + pw * 9 * 144;
    const bf16_t* XWA = (const bf16_t*)(p.ws + W_XWA) + (size_t)bl * TT * 128;
    uint4 pre[5];
    auto prefetch = [&](int t0) {
#pragma unroll
      for (int q = 0; q < 5; q++) {
        int item = lane + 64 * q;
        pre[q] = make_uint4(0, 0, 0, 0);
        if (item < 162) {
          int row = item / 18, c18 = item - row * 18;
          int t = t0 + pw * 8 - 1 + row;
          if (t >= 0 && t < TT) pre[q] = *(const uint4*)(Zb + (size_t)t * NIN + rw_rel(c18 < 16 ? c18 : 16 + c18, h, rq));
        } else if (item < 162 + 128) {
          int j = item - 162;
          int t = t0 + pw * 8 + (j >> 4);
          if (t < TT) pre[q] = *(const uint4*)(XWA + (size_t)t * 128 + (j & 15) * 8);
        }
      }
    };
    prefetch(0);
    float cst[5][8];
#pragma unroll
    for (int e = 0; e < 8; e++) {
      const int ch = h * 64 + (lane & 7) * 8 + e;
      cst[0][e] = p.w0[ch]; cst[1][e] = p.a0[ch]; cst[2][e] = p.k_k[ch]; cst[3][e] = p.k_a[ch]; cst[4][e] = p.r_k[ch];
    }
    for (int i = 0; i < RW_NC + 2; i++) {
      float* bufp = (float*)(obuf + (i & 1) * RW_BUF);
      float* rs_s = bufp;
      float* ks_s = rs_s + 32 * RLD;
      float* w_s = ks_s + 32 * RLD;
      float* a_s = w_s + 32 * RLD;
      float* na_s = a_s + 32 * RLD;
      float* vs_s = na_s + 32 * RLD;
      float* rk_s = vs_s + 512;
      if (i >= 2) {
        const float* y_s = y_all + (i & 1) * 512;
        const int t0o = (i - 2) * 32;
#pragma unroll
        for (int q = 0; q < 2; q++) {
          int item = lane + 64 * q;
          int tt = pw * 8 + (item >> 4), rl = item & 15;
          int t = t0o + tt;
          float y = y_s[tt * 16 + rl];
          float sy = red16(y), sy2 = red16(y * y);
          if (t < TT) {
            size_t mrow = (size_t)bl * TT + t;
            int col = h * 64 + rq * 16 + rl;
            YB[mrow * DM + col] = f2bf(y);
            BON[mrow * DM + col] = f2bf(rk_s[tt] * vs_s[tt * 16 + rl]);
            if (rl == 0) {
              float* d = YST + ((mrow * 16 + h) * 4 + rq) * 2;
              d[0] = sy;
              d[1] = sy2;
            }
          }
        }
        WAVE_FENCE();
      }
      if (i < RW_NC) {
        const int t0 = i * 32;
#pragma unroll
        for (int q = 0; q < 5; q++) {
          int item = lane + 64 * q;
          if (item < 162) {
            int row = item / 18, c18 = item - row * 18;
            *(uint4*)(raw_s + row * 144 + c18 * 8) = pre[q];
          } else if (item < 162 + 128) {
            int j = item - 162;
            int c16 = j & 15;
            *(uint4*)((c16 < 8 ? Xw : Xa) + (pw * 8 + (j >> 4)) * 72 + (c16 & 7) * 8) = pre[q];
          }
        }
        WAVE_FENCE();
        prefetch(t0 + 32);
        {
          auto shift8 = [&](int tl, int c18, int chm, float (&v)[8]) {
            uint4 cu = *(const uint4*)(raw_s + (tl + 1) * 144 + c18 * 8);
            uint4 pr = *(const uint4*)(raw_s + tl * 144 + c18 * 8);
            uint32_t cw[4] = {cu.x, cu.y, cu.z, cu.w}, pwd[4] = {pr.x, pr.y, pr.z, pr.w};
            float4 m0 = *(const float4*)(mu_s + chm * 8), m1 = *(const float4*)(mu_s + chm * 8 + 4);
            const float mm[8] = {m0.x, m0.y, m0.z, m0.w, m1.x, m1.y, m1.z, m1.w};
#pragma unroll
            for (int e = 0; e < 8; e++) {
              float c = bf2f((e & 1) ? (cw[e >> 1] >> 16) : (cw[e >> 1] & 0xffff));
              float q = bf2f((e & 1) ? (pwd[e >> 1] >> 16) : (pwd[e >> 1] & 0xffff));
              v[e] = c + (q - c) * mm[e];
            }
          };
          const int tl = lane >> 3, c8 = lane & 7, tt = pw * 8 + tl;
          float v[8];
          shift8(tl, c8, c8, v);
          *(float4*)(rs_s + tt * RLD + c8 * 8) = make_float4(v[0], v[1], v[2], v[3]);
          *(float4*)(rs_s + tt * RLD + c8 * 8 + 4) = make_float4(v[4], v[5], v[6], v[7]);
          shift8(tl, 8 + c8, 8 + c8, v);
          *(float4*)(ks_s + tt * RLD + c8 * 8) = make_float4(v[0], v[1], v[2], v[3]);
          *(float4*)(ks_s + tt * RLD + c8 * 8 + 4) = make_float4(v[4], v[5], v[6], v[7]);
          if (lane < 16) {
            const int tl2 = lane >> 1, c2 = lane & 1;
            shift8(tl2, 16 + c2, 32 + c2, v);
            float* d = vs_s + (pw * 8 + tl2) * 16 + c2 * 8;
            *(float4*)d = make_float4(v[0], v[1], v[2], v[3]);
            *(float4*)(d + 4) = make_float4(v[4], v[5], v[6], v[7]);
          }
        }
        WAVE_FENCE();
#pragma unroll 1
        for (int tile = 0; tile < 4; tile++) {
          const int mat = tile >> 1, ct = tile & 1;
          f32x16 acc;
#pragma unroll
          for (int r = 0; r < 16; r++) acc[r] = 0.f;
          acc = mm32((mat ? aupT : wupT) + ct * 32 * 72, 72, mat ? Xa : Xw, 72, 64, acc, lane);
          const int t = lane & 31;
          if ((t >> 3) == pw) {
#pragma unroll
            for (int g = 0; g < 4; g++) {
              const int c0 = ct * 32 + 8 * g + 4 * (lane >> 5);
              float o[4] = {acc[4 * g], acc[4 * g + 1], acc[4 * g + 2], acc[4 * g + 3]};
              *(float4*)((mat ? a_s : w_s) + t * RLD + c0) = make_float4(o[0], o[1], o[2], o[3]);
            }
          }
        }
        WAVE_FENCE();
        {
          const int tl = lane >> 3, c8 = lane & 7, tt = pw * 8 + tl;
          float* kp_ = ks_s + tt * RLD + c8 * 8;
          float* a_ = a_s + tt * RLD + c8 * 8;
          float* w_ = w_s + tt * RLD + c8 * 8;
          const float* r_ = rs_s + tt * RLD + c8 * 8;
          float* n_ = na_s + tt * RLD + c8 * 8;
          float kv[8], av[8], wv8[8], rv[8];
          *(float4*)&kv[0] = *(const float4*)kp_; *(float4*)&kv[4] = *(const float4*)(kp_ + 4);
          *(float4*)&av[0] = *(const float4*)a_; *(float4*)&av[4] = *(const float4*)(a_ + 4);
          *(float4*)&wv8[0] = *(const float4*)w_; *(float4*)&wv8[4] = *(const float4*)(w_ + 4);
          *(float4*)&rv[0] = *(const float4*)r_; *(float4*)&rv[4] = *(const float4*)(r_ + 4);
          float kk[8], ssq = 0.f, rkp = 0.f;
#pragma unroll
          for (int e = 0; e < 8; e++) {
            av[e] = sigmoidf_(av[e] + cst[1][e]);
            wv8[e] = __expf(-0.6065306597126334f * sigmoidf_(wv8[e] + cst[0][e]));
            kk[e] = kv[e] * cst[2][e];
            ssq += kk[e] * kk[e];
            kv[e] = kv[e] * (1.f + (av[e] - 1.f) * cst[3][e]);
            rkp += rv[e] * kv[e] * cst[4][e];
          }
          ssq += dpp_f<0xB1>(ssq); ssq += dpp_f<0x4E>(ssq); ssq += dpp_f<0x141>(ssq);
          rkp += dpp_f<0xB1>(rkp); rkp += dpp_f<0x4E>(rkp); rkp += dpp_f<0x141>(rkp);
          const float sc = rsqrtf(ssq + 1e-6f);
#pragma unroll
          for (int e = 0; e < 8; e++) { kk[e] *= sc; av[e] *= kk[e]; kk[e] = -kk[e]; }
          *(float4*)n_ = make_float4(kk[0], kk[1], kk[2], kk[3]); *(float4*)(n_ + 4) = make_float4(kk[4], kk[5], kk[6], kk[7]);
          *(float4*)a_ = make_float4(av[0], av[1], av[2], av[3]); *(float4*)(a_ + 4) = make_float4(av[4], av[5], av[6], av[7]);
          *(float4*)kp_ = make_float4(kv[0], kv[1], kv[2], kv[3]); *(float4*)(kp_ + 4) = make_float4(kv[4], kv[5], kv[6], kv[7]);
          *(float4*)w_ = make_float4(wv8[0], wv8[1], wv8[2], wv8[3]); *(float4*)(w_ + 4) = make_float4(wv8[4], wv8[5], wv8[6], wv8[7]);
          if (c8 == 0) rk_s[tt] = rkp;
        }
      }
      lds_barrier();
    }
  } else {
    float s0 = 0.f, s1 = 0.f, s2 = 0.f, s3 = 0.f;
    const int row_l = (tid >> 4) & 15, kq = tid & 15;
    for (int i = 0; i < RW_NC + 2; i++) {
      if (i >= 1 && i <= RW_NC) {
        typedef float f4v __attribute__((ext_vector_type(4)));
        typedef const __attribute__((address_space(3))) float* ldsf;
        typedef __attribute__((address_space(3))) float* ldsfw;
        const float* bufp = (const float*)(obuf + ((i - 1) & 1) * RW_BUF);
        ldsf rs_s = (ldsf)(bufp + kq * 4);
        ldsf ks_s = rs_s + 32 * RLD;
        ldsf w_s = ks_s + 32 * RLD;
        ldsf a_s = w_s + 32 * RLD;
        ldsf na_s = a_s + 32 * RLD;
        ldsf vs_s = (ldsf)(bufp + 5 * 32 * RLD + row_l);
        ldsfw y_s = (ldsfw)(kq == 0 ? (y_all + ((i - 1) & 1) * 512 + row_l) : (float*)(smem + 143808) + tid);
        asm volatile("" : "+v"(rs_s), "+v"(ks_s), "+v"(w_s), "+v"(a_s), "+v"(na_s), "+v"(vs_s), "+v"(y_s));
        typedef float v2f __attribute__((ext_vector_type(2)));
        f4v a4 = *(const __attribute__((address_space(3))) f4v*)(na_s), w4 = *(const __attribute__((address_space(3))) f4v*)(w_s), b4 = *(const __attribute__((address_space(3))) f4v*)(a_s),
               k4 = *(const __attribute__((address_space(3))) f4v*)(ks_s), r4 = *(const __attribute__((address_space(3))) f4v*)(rs_s);
        float vv = vs_s[0];
        v2f s01 = {s0, s1}, s23 = {s2, s3};
#pragma unroll 8
        for (int tt = 0; tt < 32; tt++) {
          const int tn = (tt + 1) & 31;
          f4v a4n = *(const __attribute__((address_space(3))) f4v*)(na_s + tn * RLD), w4n = *(const __attribute__((address_space(3))) f4v*)(w_s + tn * RLD),
                 b4n = *(const __attribute__((address_space(3))) f4v*)(a_s + tn * RLD), k4n = *(const __attribute__((address_space(3))) f4v*)(ks_s + tn * RLD),
                 r4n = *(const __attribute__((address_space(3))) f4v*)(rs_s + tn * RLD);
          float vvn = vs_s[tn * 16];
          const v2f a01 = {a4.x, a4.y}, a23 = {a4.z, a4.w}, w01 = {w4.x, w4.y}, w23 = {w4.z, w4.w};
          const v2f b01 = {b4.x, b4.y}, b23 = {b4.z, b4.w}, k01 = {k4.x, k4.y}, k23 = {k4.z, k4.w};
          const v2f r01 = {r4.x, r4.y}, r23 = {r4.z, r4.w}, vv2 = {vv, vv};
          v2f pd = s01 * a01 + s23 * a23;
          v2f t01 = s01 * w01 + vv2 * k01, t23 = s23 * w23 + vv2 * k23;
          float sa = red16(pd.x + pd.y);
          const v2f sa2 = {sa, sa};
          s01 = t01 + sa2 * b01;
          s23 = t23 + sa2 * b23;
          v2f py = s01 * r01 + s23 * r23;
          float y = red16(py.x + py.y);
          y_s[tt * 16] = y;
          a4 = a4n; w4 = w4n; b4 = b4n; k4 = k4n; r4 = r4n; vv = vvn;
        }
        s0 = s01.x; s1 = s01.y; s2 = s23.x; s3 = s23.y;
      }
      lds_barrier();
    }
  }
  __syncthreads();
}

__device__ __forceinline__ void delta_block(const P& p, char* smem, int unit, int sl) {
  const int tid0 = otid();
  const int bl = unit >> 3, h = unit & 7;
  float* gc_s = (float*)smem;
  float* be_s = gc_s + 64;
  bf16_t* qn = (bf16_t*)(smem + 512);
  bf16_t* kn = qn + 64 * 136;
  bf16_t* wk = kn + 64 * 136;
  bf16_t* knT = wk + 64 * 136;
  bf16_t* ktT = knT + 128 * 72;
  bf16_t* Tb = ktT + 128 * 72;
  bf16_t* Tbg = Tb + 64 * 72;
  bf16_t* attn = Tbg + 64 * 72;
  bf16_t* vT = attn + 64 * 72;
  bf16_t* vnT = vT + 32 * 72;
  bf16_t* ST = vnT + 32 * 72;
  const bf16_t* z = (const bf16_t*)(p.ws + W_Z);
  const bf16_t* Zb = z + (size_t)bl * TT * NIN;
  const float* GB = (const float*)(p.ws + W_GB);
  const float* BB = (const float*)(p.ws + W_BB);
  const bf16_t* TTb = (const bf16_t*)(p.ws + W_TT);
  bf16_t* OA = (bf16_t*)(p.ws + W_OA);
  float* OST = (float*)(p.ws + W_OST);
  float* cw_s = (float*)(ST + 32 * 136);
  bf16_t* o_s = (bf16_t*)(cw_s + 4 * 288);
  for (int e = tid0; e < 32 * 136; e += 512) ST[e] = 0;
  for (int e = tid0; e < 4 * 288; e += 512) {
    int j = e / 288, c = e - j * 288;
    int zc = c < 128 ? h * 128 + c : (c < 256 ? 1024 + h * 128 + (c - 128) : 2048 + h * 128 + sl * 32 + (c - 256));
    cw_s[e] = p.conv_w[j * 3072 + zc];
  }
  uint4 praw[7], vraw[7];
  const int c_role = tid0 >> 8, c_rg = (tid0 & 255) >> 4, c_cgp = tid0 & 15;
  const int c_zc = (c_role ? 1024 : 0) + h * 128 + c_cgp * 8;
  const int v_rg = tid0 >> 2, v_zc = 2048 + h * 128 + sl * 32 + (tid0 & 3) * 8;
  auto prefetch_raw = [&](int n) {
    const int tb = n * 64 - 48;
#pragma unroll
    for (int i = 0; i < 7; i++) {
      int t = tb + 4 * c_rg - 3 + i;
      praw[i] = make_uint4(0, 0, 0, 0);
      if (n < NCHUNK && t >= 0) praw[i] = *(const uint4*)(Zb + (size_t)t * NIN + c_zc);
      int tv = tb + 4 * v_rg - 3 + i;
      vraw[i] = make_uint4(0, 0, 0, 0);
      if (n < NCHUNK && tid0 < 64 && tv >= 0) vraw[i] = *(const uint4*)(Zb + (size_t)tv * NIN + v_zc);
    }
  };
  uint4 Tpre = make_uint4(0, 0, 0, 0);
  float gpre = 0.f, bpre = 0.f;
  auto prefetch_small = [&](int n) {
    if (n < NCHUNK) {
      const size_t task = (size_t)unit * NCHUNK + n;
      Tpre = *(const uint4*)(TTb + task * 4096 + (tid0 >> 3) * 64 + (tid0 & 7) * 8);
      if (tid0 < 64) { gpre = GB[task * 64 + tid0]; bpre = BB[task * 64 + tid0]; }
    }
  };
  auto flush_o = [&](int n) {
    const int c = tid0 >> 3, part = tid0 & 7;
    const int t = n * 64 - 48 + c;
    uint2 raw = *(const uint2*)(o_s + c * 36 + part * 4);
    float a0 = bf2f(raw.x & 0xffff), a1 = bf2f(raw.x >> 16), a2 = bf2f(raw.y & 0xffff), a3 = bf2f(raw.y >> 16);
    float sq = a0 * a0 + a1 * a1 + a2 * a2 + a3 * a3;
    sq += dpp_f<0xB1>(sq); sq += dpp_f<0x4E>(sq); sq += dpp_f<0x141>(sq);
    if (t >= 0) {
      size_t mrow = (size_t)bl * TT + t;
      *(uint2*)(OA + mrow * DM + h * 128 + sl * 32 + part * 4) = raw;
      if (part == 0) OST[(mrow * 8 + h) * 4 + sl] = sq;
    }
  };
  prefetch_raw(0);
  prefetch_small(0);
  f32x16 R;
#pragma unroll
  for (int r = 0; r < 16; r++) R[r] = 0.f;
  __syncthreads();
  for (int n = 0; n < NCHUNK; n++) {
    int tid = tid0;
    asm volatile("" : "+v"(tid));
    int lane = tid & 63, wv = tid >> 6;
    const int task = unit * NCHUNK + n;
    const int tbase = n * 64 - 48;
    if (tid < 64) { gc_s[tid] = gpre; be_s[tid] = bpre; }
    if (n > 0) flush_o(n - 1);
    lds_barrier();
    const float gl = gc_s[63];
    {
      const int cbase = c_role * 128 + c_cgp * 8;
      float cwv[4][8];
#pragma unroll
      for (int j = 0; j < 4; j++) {
        float4 w0 = *(const float4*)(cw_s + j * 288 + cbase), w1 = *(const float4*)(cw_s + j * 288 + cbase + 4);
        cwv[j][0] = w0.x; cwv[j][1] = w0.y; cwv[j][2] = w0.z; cwv[j][3] = w0.w;
        cwv[j][4] = w1.x; cwv[j][5] = w1.y; cwv[j][6] = w1.z; cwv[j][7] = w1.w;
      }
      uint32_t kpk[4][4];
#pragma unroll
      for (int rr = 0; rr < 4; rr++)
#pragma unroll
        for (int e = 0; e < 4; e++) kpk[rr][e] = 0u;
#pragma unroll
      for (int rr = 0; rr < 4; rr++) {
        const int row = 4 * c_rg + rr;
        float o[8];
#pragma unroll
        for (int e = 0; e < 8; e++) o[e] = 0.f;
#pragma unroll
        for (int j = 0; j < 4; j++) {
          const uint4 rw = praw[rr + j];
          const uint32_t w[4] = {rw.x, rw.y, rw.z, rw.w};
#pragma unroll
          for (int e = 0; e < 8; e++) o[e] += bf2f((e & 1) ? (w[e >> 1] >> 16) : (w[e >> 1] & 0xffff)) * cwv[j][e];
        }
        float s = 0.f;
#pragma unroll
        for (int e = 0; e < 8; e++) { o[e] = siluf_(o[e]); s += o[e] * o[e]; }
        s = red16(s);
        float sc = rsqrtf(s + 1e-6f);
        if (c_role == 0) {
          sc *= 0.08838834764831845f;
          *(uint4*)(qn + row * 136 + c_cgp * 8) =
              make_uint4(pack2(o[0] * sc, o[1] * sc), pack2(o[2] * sc, o[3] * sc), pack2(o[4] * sc, o[5] * sc),
                         pack2(o[6] * sc, o[7] * sc));
        } else {
          uint32_t pk[4];
#pragma unroll
          for (int e = 0; e < 4; e++) pk[e] = pack2(o[2 * e] * sc, o[2 * e + 1] * sc);
          *(uint4*)(kn + row * 136 + c_cgp * 8) = make_uint4(pk[0], pk[1], pk[2], pk[3]);
#pragma unroll
          for (int e = 0; e < 4; e++) kpk[rr][e] = pk[e];
        }
      }
      if (c_role == 1) {
#pragma unroll
        for (int e = 0; e < 8; e++) {
          const int sh = (e & 1) * 16;
          const uint32_t r0 = (kpk[0][e >> 1] >> sh) & 0xffffu, r1 = (kpk[1][e >> 1] >> sh) & 0xffffu,
                         r2 = (kpk[2][e >> 1] >> sh) & 0xffffu, r3 = (kpk[3][e >> 1] >> sh) & 0xffffu;
          *(uint2*)(knT + (c_cgp * 8 + e) * 72 + 4 * c_rg) = make_uint2(r0 | (r1 << 16), r2 | (r3 << 16));
        }
      }
      if (tid < 64) {
        const int vb = 256 + (tid & 3) * 8;
        bf16_t vpk[4][8];
#pragma unroll
        for (int rr = 0; rr < 4; rr++) {
          float o[8];
#pragma unroll
          for (int e = 0; e < 8; e++) o[e] = 0.f;
#pragma unroll
          for (int j = 0; j < 4; j++) {
            const uint4 rw = vraw[rr + j];
            const uint32_t w[4] = {rw.x, rw.y, rw.z, rw.w};
#pragma unroll
            for (int e = 0; e < 8; e++)
              o[e] += bf2f((e & 1) ? (w[e >> 1] >> 16) : (w[e >> 1] & 0xffff)) * cw_s[j * 288 + vb + e];
          }
#pragma unroll
          for (int e = 0; e < 8; e++) vpk[rr][e] = f2bf(siluf_(o[e]));
        }
#pragma unroll
        for (int e = 0; e < 8; e++)
          *(uint2*)(vT + ((tid & 3) * 8 + e) * 72 + 4 * v_rg) =
              make_uint2((uint32_t)vpk[0][e] | ((uint32_t)vpk[1][e] << 16), (uint32_t)vpk[2][e] | ((uint32_t)vpk[3][e] << 16));
      }
      prefetch_raw(n + 1);
    }
    {
      int c = tid >> 3, sb = (tid & 7) * 8;
      uint4 raw = Tpre;
      uint32_t w[4] = {raw.x, raw.y, raw.z, raw.w};
      uint32_t ob[4], og[4];
#pragma unroll
      for (int e = 0; e < 4; e++) {
        float t0v = bf2f(w[e] & 0xffff), t1v = bf2f(w[e] >> 16);
        int s0i = sb + 2 * e, s1i = s0i + 1;
        float b0 = be_s[s0i], b1 = be_s[s1i];
        ob[e] = pack2(t0v * b0, t1v * b1);
        og[e] = pack2(t0v * b0 * __expf(gc_s[s0i]), t1v * b1 * __expf(gc_s[s1i]));
      }
      *(uint4*)(Tb + c * 72 + sb) = make_uint4(ob[0], ob[1], ob[2], ob[3]);
      *(uint4*)(Tbg + c * 72 + sb) = make_uint4(og[0], og[1], og[2], og[3]);
      prefetch_small(n + 1);
    }
    lds_barrier();
    tid = tid0; asm volatile("" : "+v"(tid)); lane = tid & 63; wv = tid >> 6;
    {
      const int ta = wv == 0 ? 0 : wv == 1 ? 4 : wv == 2 ? 1 : wv == 3 ? 5 : wv == 5 ? 3 : -1;
      const int tb2 = wv == 2 ? 2 : wv == 3 ? 6 : wv == 5 ? 7 : -1;
#pragma unroll 1
      for (int q = 0; q < 2; q++) {
        const int t8 = q == 0 ? ta : tb2;
        if (t8 >= 0) {
          const int ti = t8 >> 2, tj = t8 & 3;
          f32x16 acc;
#pragma unroll
          for (int r = 0; r < 16; r++) acc[r] = 0.f;
          acc = mm32(Tbg + ti * 32 * 72, 72, knT + tj * 32 * 72, 72, 64, acc, lane);
#pragma unroll
          for (int r = 0; r < 16; r++) wk[(ti * 32 + rowof(r, lane)) * 136 + tj * 32 + (lane & 31)] = f2bf(acc[r]);
        }
      }
    }
    if (wv == 5) {
#pragma unroll
      for (int r = 0; r < 16; r++) attn[rowof(r, lane) * 72 + 32 + (lane & 31)] = 0;
    } else if (wv >= 4) {
      const int ci = (wv - 4) >> 1, si = (wv - 4) & 1;
      f32x16 acc;
#pragma unroll
      for (int r = 0; r < 16; r++) acc[r] = 0.f;
      acc = mm32(qn + ci * 32 * 136, 136, kn + si * 32 * 136, 136, 128, acc, lane);
#pragma unroll
      for (int r = 0; r < 16; r++) {
        int c = ci * 32 + rowof(r, lane), s = si * 32 + (lane & 31);
        float v = (c >= s) ? acc[r] * __expf(gc_s[c] - gc_s[s]) : 0.f;
        attn[c * 72 + s] = f2bf(v);
      }
    } else if (wv < 2) {
#pragma unroll
      for (int r = 0; r < 16; r++) R[r] = 0.f;
      R = mm32(Tb + wv * 32 * 72, 72, vT, 72, 64, R, lane);
    }
    lds_barrier();
    tid = tid0; asm volatile("" : "+v"(tid)); lane = tid & 63; wv = tid >> 6;
    if (wv < 2) {
      f32x16 acc;
#pragma unroll
      for (int r = 0; r < 16; r++) acc[r] = 0.f;
      acc = mm32(wk + wv * 32 * 136, 136, ST, 136, 128, acc, lane);
      const int dv = lane & 31;
#pragma unroll
      for (int g = 0; g < 4; g++) {
        int c0 = wv * 32 + 8 * g + 4 * (lane >> 5);
        float v0 = R[4 * g] - acc[4 * g], v1 = R[4 * g + 1] - acc[4 * g + 1], v2 = R[4 * g + 2] - acc[4 * g + 2],
              v3 = R[4 * g + 3] - acc[4 * g + 3];
        *(uint2*)(vnT + dv * 72 + c0) = make_uint2(pack2(v0, v1), pack2(v2, v3));
        *(uint2*)(ktT + dv * 72 + c0) =
            make_uint2(pack2(v0 * __expf(gl - gc_s[c0]), v1 * __expf(gl - gc_s[c0 + 1])),
                       pack2(v2 * __expf(gl - gc_s[c0 + 2]), v3 * __expf(gl - gc_s[c0 + 3])));
      }
    } else if (wv < 4) {
      const int ti = wv - 2;
#pragma unroll
      for (int r = 0; r < 16; r++) R[r] = 0.f;
      R = mm32(qn + ti * 32 * 136, 136, ST, 136, 128, R, lane);
#pragma unroll
      for (int r = 0; r < 16; r++) R[r] *= __expf(gc_s[ti * 32 + rowof(r, lane)]);
    }
    lds_barrier();
    tid = tid0; asm volatile("" : "+v"(tid)); lane = tid & 63; wv = tid >> 6;
    if (wv >= 2 && wv < 4) {
      const int ti = wv - 2;
      R = mm32(attn + ti * 32 * 72, 72, vnT, 72, 64, R, lane);
      const int dv = lane & 31;
#pragma unroll
      for (int r = 0; r < 16; r++) o_s[(ti * 32 + rowof(r, lane)) * 36 + dv] = f2bf(R[r]);
    } else if (wv >= 4) {
      const int di = wv - 4;
      const float eg = __expf(gl);
#pragma unroll
      for (int r = 0; r < 16; r++) R[r] *= eg;
      R = mm32(knT + di * 32 * 72, 72, ktT, 72, 64, R, lane);
      const int dv = lane & 31;
#pragma unroll
      for (int g = 0; g < 4; g++) {
        int d0 = di * 32 + 8 * g + 4 * (lane >> 5);
        *(uint2*)(ST + dv * 136 + d0) =
            make_uint2(pack2(R[4 * g], R[4 * g + 1]), pack2(R[4 * g + 2], R[4 * g + 3]));
      }
    }
    lds_barrier();
  }
  flush_o(NCHUNK - 1);
  __syncthreads();
}

__device__ __forceinline__ void phase_final(const P& p) {
  const float* h3 = (const float*)(p.ws + W_H3);
  const float* ss = (const float*)(p.ws + W_SS) + 3 * MTOT;
  const int tid_ = otid();
  const int lane = tid_ & 63, wv = tid_ >> 6;
  for (int r = blockIdx.x * 8 + wv; r < NB * SEQ; r += gridDim.x * 8) {
    int b = r / SEQ, t = r - b * SEQ;
    int m = b * TT + NMETA + t;
    float rs = rsqrtf(ss[m] * (1.f / DM) + EPS);
    float4 v4[4], g4[4];
#pragma unroll
    for (int q = 0; q < 4; q++) {
      int c = q * 256 + lane * 4;
      v4[q] = *(const float4*)(h3 + (size_t)m * DM + c);
      g4[q] = *(const float4*)(p.final_norm + c);
    }
#pragma unroll
    for (int q = 0; q < 4; q++) {
      int c = q * 256 + lane * 4;
      float4 v = v4[q], g = g4[q];
      *(float4*)(p.out + (size_t)r * DM + c) = make_float4(v.x * rs * g.x, v.y * rs * g.y, v.z * rs * g.z, v.w * rs * g.w);
    }
  }
}


DEV void grid_barrier(unsigned* bar, unsigned& epoch) {
  __syncthreads();
  if (threadIdx.x == 0) {
    epoch++;
    const unsigned g = blockIdx.x & 7u;
    const unsigned gsize = (gridDim.x >> 3) + ((gridDim.x & 7u) > g ? 1u : 0u);
    const unsigned ngroups = gridDim.x < 8u ? gridDim.x : 8u;
    __builtin_amdgcn_fence(__ATOMIC_RELEASE, "agent");
    asm volatile("s_waitcnt vmcnt(0) lgkmcnt(0)" ::: "memory");
    unsigned v = __hip_atomic_fetch_add(&bar[g * 64], 1u, __ATOMIC_RELAXED, __HIP_MEMORY_SCOPE_AGENT) + 1u;
    if (v == gsize * epoch) __hip_atomic_fetch_add(&bar[512], 1u, __ATOMIC_RELAXED, __HIP_MEMORY_SCOPE_AGENT);
    while (__hip_atomic_load(&bar[512], __ATOMIC_RELAXED, __HIP_MEMORY_SCOPE_AGENT) < ngroups * epoch)
      __builtin_amdgcn_s_sleep(1);
    __builtin_amdgcn_fence(__ATOMIC_ACQUIRE, "agent");
    asm volatile("s_waitcnt vmcnt(0) lgkmcnt(0)" ::: "memory");
  }
  __syncthreads();
}

__global__ void __launch_bounds__(512) mega(P p) {
  extern __shared__ __attribute__((aligned(16))) char smem[];
  cg::grid_group grid = cg::this_grid();
  unsigned* bar = (unsigned*)(p.ws + W_BAR);
  unsigned epoch = 0;
#ifdef USE_CG_SYNC
#define GSYNC() grid.sync()
#else
#define GSYNC() grid_barrier(bar, epoch)
#endif
  const bf16_t* arena = (const bf16_t*)p.out;
  const bf16_t* hb = (const bf16_t*)(p.ws + W_HB);
  const bf16_t* act = (const bf16_t*)(p.ws + W_ACT);
  const bf16_t* z = (const bf16_t*)(p.ws + W_Z);
  const bf16_t* sg = (const bf16_t*)(p.ws + W_SG);

  phase0(p, smem);
  grid.sync();
  gemm_big<EPI_SWIGLU>(p, smem, hb, DM, MTOT, arena + A_WGU1, DM, 22, 0);
  GSYNC();
  gemm_phase<EPI_DOWN1>(p, smem, act, DFF, MTOT, arena + A_WD1, DFF, 8, 0);
  GSYNC();
  const bf16_t* oab = (const bf16_t*)(p.ws + W_OA);
  gemm_big<EPI_WIN>(p, smem, hb, DM, MH, arena + A_WIN, DM, 38, 0);
  GSYNC();
  for (int half = 0; half < 2; half++) {
    phase4(p, smem);
    GSYNC();
    for (int job = blockIdx.x; job < 192; job += gridDim.x) {
      {
      if (job < 128) rwkv_block(p, smem, job >> 2, job & 3);
      else delta_block(p, smem, (job - 128) >> 2, (job - 128) & 3);
      }
      __syncthreads();
    }
    GSYNC();
    gemm_phase<EPI_MERGE>(p, smem, sg, 192, MH, arena + A_GUP, 192, 8, half);
    GSYNC();
    gemm_phase<EPI_WOUT>(p, smem, oab, DM, MH, arena + A_WOUT, DM, 8, half);
    if (half == 0) gemm_big<EPI_WIN>(p, smem, hb + (size_t)MH * DM, DM, MH, arena + A_WIN, DM, 38, 1);
    GSYNC();
  }
  gemm_big<EPI_SWIGLU>(p, smem, hb, DM, MTOT, arena + A_WGU2, DM, 22, 1);
  GSYNC();
  gemm_phase<EPI_DOWN2>(p, smem, act, DFF, MTOT, arena + A_WD2, DFF, 8, 0);
  GSYNC();
  phase_final(p);
}

extern "C" void kernel_launch(void* const* d_in, const int* in_sizes, int n_in, void* d_out, int out_size, void* d_ws,
                              size_t ws_size, hipStream_t stream) {
  static int grid_blocks = 0;
  if (!grid_blocks) {
    int dev = 0, cus = 0, per_cu = 0;
    hipGetDevice(&dev);
    hipDeviceGetAttribute(&cus, hipDeviceAttributeMultiprocessorCount, dev);
    hipFuncSetAttribute((const void*)mega, hipFuncAttributeMaxDynamicSharedMemorySize, LDS_BYTES);
    hipOccupancyMaxActiveBlocksPerMultiprocessor(&per_cu, mega, 512, LDS_BYTES);
    if (per_cu < 1) per_cu = 1;
    if (per_cu > 1) per_cu = 1;
    grid_blocks = cus * per_cu;
  }
  P p{};
  const float* const* in = (const float* const*)d_in;
  p.x = in[0]; p.meta = in[1]; p.ffn1_norm = in[2]; p.ffn1_wgu = in[3]; p.ffn1_wd = in[4]; p.mix_norm = in[5];
  p.w_in = in[6]; p.conv_w = in[7]; p.log_rate = in[8]; p.dt_bias = in[9]; p.out_norm = in[10]; p.mu = in[11];
  p.w0 = in[12]; p.w_up = in[13]; p.a0 = in[14]; p.a_up = in[15]; p.g_up = in[16]; p.k_k = in[17]; p.k_a = in[18];
  p.r_k = in[19]; p.ln_g = in[20]; p.ln_b = in[21]; p.w_out = in[22]; p.ffn2_norm = in[23]; p.ffn2_wgu = in[24];
  p.ffn2_wd = in[25]; p.final_norm = in[26];
  p.out = (float*)d_out;
  p.ws = (char*)d_ws;
  (void)hipMemsetAsync((char*)d_ws + W_BAR, 0, 4096, stream);
  void* args[] = {&p};
  hipError_t e = hipLaunchCooperativeKernel((void*)mega, dim3(grid_blocks), dim3(512), args, LDS_BYTES, stream);
  if (e != hipSuccess) fprintf(stderr, "cooperative launch failed: %s (grid %d)\n", hipGetErrorString(e), grid_blocks);
}
```
